# Optimizing an MI355X kernel written in HIP

```python
import math
import jax, jax.numpy as jnp
from jax import lax
import numpy as np

D_MODEL = 1024
BATCH = 8
SEQ = 4096
DEPTH = 1

D_MIX = D_MODEL
D_NSA = D_MIX // 2
D_GMLP = D_MIX - D_NSA
HEAD_DIM = 64
N_HEADS = D_NSA // HEAD_DIM
N_KV = 2
Q_PER_KV = N_HEADS // N_KV
CMP_BLOCK = 32
CMP_STRIDE = 16
CMP_HIDDEN = 256
SEL_BLOCK = 64
N_SEL = 16
WINDOW = 512
Q_BLOCK = 64
GMLP_CHUNK = 128
GMLP_GROUPS = 8
GMLP_GDIM = D_GMLP // GMLP_GROUPS
D_FF = 4 * D_MODEL
D_PLE = 256
EPS = 1e-6
FORCED_SCORE = 1e4
KV_COLS = N_KV * HEAD_DIM
COL_SIZES = [D_NSA, KV_COLS, KV_COLS, KV_COLS, KV_COLS, KV_COLS, KV_COLS, 3 * N_HEADS, D_GMLP, D_GMLP]
COL_OFFS = [int(v) for v in np.concatenate([[0], np.cumsum(COL_SIZES)])]
IN_COLS = COL_OFFS[-1]

kernel_name = "hybrid_nsa_gmlp_block"


def alibi_slopes():
    s = np.array([2.0 ** (-8.0 * (h + 1) / N_HEADS) for h in range(N_HEADS)], np.float32)
    return s.reshape(N_KV, Q_PER_KV)


def rmsnorm(x, g):
    xf = x.astype(jnp.float32)
    y = xf * lax.rsqrt(jnp.mean(xf * xf, axis=-1, keepdims=True) + EPS)
    return (y * g.astype(jnp.float32)).astype(x.dtype)


def layernorm(x, g, b):
    xf = x.astype(jnp.float32)
    mu = jnp.mean(xf, axis=-1, keepdims=True)
    var = jnp.mean(jnp.square(xf - mu), axis=-1, keepdims=True)
    y = (xf - mu) * lax.rsqrt(var + EPS)
    return (y * g.astype(jnp.float32) + b.astype(jnp.float32)).astype(x.dtype)


def masked_softmax(s, mask):
    s = jnp.where(mask, s, -jnp.inf)
    m = jnp.max(s, axis=-1, keepdims=True)
    m = jnp.where(jnp.isfinite(m), m, 0.0)
    e = jnp.exp(s - m)
    return e / jnp.maximum(jnp.sum(e, axis=-1, keepdims=True), 1e-30)


def compress(kv, pos, w1, b1, w2, b2):
    B, T = kv.shape[0], kv.shape[1]
    c = CMP_BLOCK // CMP_STRIDE
    nch = T // CMP_STRIDE
    nc = nch - c + 1
    kc = kv.reshape(B, nch, CMP_STRIDE, N_KV, HEAD_DIM)
    blocks = jnp.concatenate([kc[:, i:i + nc] for i in range(c)], axis=2)
    blocks = blocks + pos[None, None, :, None, :]
    flat = blocks.transpose(0, 1, 3, 2, 4).reshape(B, nc, N_KV, CMP_BLOCK * HEAD_DIM)
    hdn = jax.nn.gelu(flat @ w1 + b1)
    return hdn @ w2 + b2


def nsa_attention(q, k_c, v_c, k_s, v_s, k_w, v_w, gates):
    B, T = q.shape[0], q.shape[1]
    nc = k_c.shape[1]
    nb = T // SEL_BLOCK
    n_sel = min(N_SEL, nb)
    r = SEL_BLOCK // CMP_STRIDE
    c = CMP_BLOCK // CMP_STRIDE
    w_imp = [float(v) for v in np.convolve(np.ones(r), np.ones(c))]
    span = r * (nb - 1) + 1
    scale = HEAD_DIM ** -0.5
    slopes = jnp.asarray(alibi_slopes())[None, :, :, None, None]
    pos_c_end = jnp.arange(nc, dtype=jnp.int32) * CMP_STRIDE + (CMP_BLOCK - 1)
    pos_c_mid = jnp.arange(nc, dtype=jnp.int32).astype(jnp.float32) * CMP_STRIDE + (CMP_BLOCK - 1) / 2.0
    ks_blk = k_s.reshape(B, nb, SEL_BLOCK, N_KV, HEAD_DIM).transpose(0, 3, 1, 2, 4)
    vs_blk = v_s.reshape(B, nb, SEL_BLOCK, N_KV, HEAD_DIM).transpose(0, 3, 1, 2, 4)
    kw_pad = jnp.pad(k_w, ((0, 0), (WINDOW, 0), (0, 0), (0, 0)))
    vw_pad = jnp.pad(v_w, ((0, 0), (WINDOW, 0), (0, 0), (0, 0)))
    bi = jnp.arange(B)[:, None, None, None]
    gi = jnp.arange(N_KV)[None, :, None, None]
    blk = jnp.arange(nb, dtype=jnp.int32)

    def one_block(qb):
        q0 = qb * Q_BLOCK
        t = q0 + jnp.arange(Q_BLOCK, dtype=jnp.int32)
        tf = t.astype(jnp.float32)
        qq = lax.dynamic_slice_in_dim(q, q0, Q_BLOCK, axis=1)
        gg = lax.dynamic_slice_in_dim(gates, q0, Q_BLOCK, axis=1)
        s = jnp.einsum('bqgrd,bcgd->bgrqc', qq, k_c).astype(jnp.float32) * scale
        s = s - slopes * jnp.abs(tf[:, None] - pos_c_mid[None, :])
        p_c = masked_softmax(s, pos_c_end[None, :] <= t[:, None])
        o_c = jnp.einsum('bgrqc,bcgd->bqgrd', p_c.astype(v_c.dtype), v_c)
        imp_c = jnp.pad(jnp.sum(p_c, axis=2), ((0, 0), (0, 0), (0, 0), (c - 1, c - 1)))
        imp = w_imp[0] * imp_c[..., 0:span:r]
        for k in range(1, r + c - 1):
            imp = imp + w_imp[k] * imp_c[..., k:k + span:r]
        cur = t // SEL_BLOCK
        forced = (blk[None, :] == 0) | (blk[None, :] == cur[:, None]) | (blk[None, :] == cur[:, None] - 1)
        visible = blk[None, :] * SEL_BLOCK <= t[:, None]
        imp = jnp.where(forced, FORCED_SCORE, imp)
        imp = jnp.where(visible, imp, -1.0)
        _, idx = lax.top_k(imp, n_sel)
        k_g = ks_blk[bi, gi, idx].reshape(B, N_KV, Q_BLOCK, n_sel * SEL_BLOCK, HEAD_DIM)
        v_g = vs_blk[bi, gi, idx].reshape(B, N_KV, Q_BLOCK, n_sel * SEL_BLOCK, HEAD_DIM)
        pos_s = (idx[..., None] * SEL_BLOCK + jnp.arange(SEL_BLOCK, dtype=jnp.int32)).reshape(
            B, N_KV, Q_BLOCK, n_sel * SEL_BLOCK)
        dist_s = tf[None, None, :, None] - pos_s.astype(jnp.float32)
        s = jnp.einsum('bqgrd,bgqkd->bgrqk', qq, k_g).astype(jnp.float32) * scale
        s = s - slopes * dist_s[:, :, None]
        p_s = masked_softmax(s, (dist_s >= 0.0)[:, :, None])
        o_s = jnp.einsum('bgrqk,bgqkd->bqgrd', p_s.astype(v_g.dtype), v_g)
        kw = lax.dynamic_slice_in_dim(kw_pad, q0, WINDOW + Q_BLOCK, axis=1)
        vw = lax.dynamic_slice_in_dim(vw_pad, q0, WINDOW + Q_BLOCK, axis=1)
        pos_w = q0 - WINDOW + jnp.arange(WINDOW + Q_BLOCK, dtype=jnp.int32)
        dw = t[:, None] - pos_w[None, :]
        mask_w = (dw >= 0) & (dw < WINDOW) & (pos_w[None, :] >= 0)
        s = jnp.einsum('bqgrd,bkgd->bgrqk', qq, kw).astype(jnp.float32) * scale
        s = s - slopes * dw.astype(jnp.float32)
        p_w = masked_softmax(s, mask_w)
        o_w = jnp.einsum('bgrqk,bkgd->bqgrd', p_w.astype(vw.dtype), vw)
        return gg[..., 0:1] * o_c + gg[..., 1:2] * o_s + gg[..., 2:3] * o_w

    out = lax.map(one_block, jnp.arange(T // Q_BLOCK, dtype=jnp.int32))
    return out.transpose(1, 0, 2, 3, 4, 5).reshape(B, T, N_HEADS * HEAD_DIM)


def gmlp_mix(u, v, ln_g, ln_b, ws, bs):
    B, T = u.shape[0], u.shape[1]
    vn = layernorm(v, ln_g, ln_b)
    vc = vn.reshape(B, T // GMLP_CHUNK, GMLP_CHUNK, GMLP_GROUPS, GMLP_GDIM)
    w = ws * jnp.tril(jnp.ones((GMLP_CHUNK, GMLP_CHUNK), ws.dtype))
    mixed = jnp.einsum('gts,bcsgd->bctgd', w, vc) + bs.T[None, None, :, :, None]
    return u * mixed.reshape(B, T, D_GMLP)


def setup_inputs(seed: int = 0) -> dict:
    key = jax.random.key(seed)
    ks = jax.random.split(key, 40)
    L = DEPTH

    def nrm(k, shape, s):
        return jax.random.normal(k, shape, jnp.float32) * s

    def gain(k, shape):
        return 1.0 + 0.05 * jax.random.normal(k, shape, jnp.float32)

    return {
        "x": nrm(ks[0], (BATCH, SEQ, D_MODEL), 1.0),
        "p": nrm(ks[1], (DEPTH, BATCH, SEQ, D_PLE), 1.0),
        "g_mix": gain(ks[2], (L, D_MODEL)),
        "w_in": nrm(ks[3], (L, D_MODEL, IN_COLS), D_MODEL ** -0.5),
        "q_norm_g": gain(ks[4], (L, HEAD_DIM)),
        "kc_norm_g": gain(ks[5], (L, HEAD_DIM)),
        "ks_norm_g": gain(ks[6], (L, HEAD_DIM)),
        "kw_norm_g": gain(ks[7], (L, HEAD_DIM)),
        "cmp_pos_k": nrm(ks[8], (L, CMP_BLOCK, HEAD_DIM), 0.1),
        "cmp_pos_v": nrm(ks[9], (L, CMP_BLOCK, HEAD_DIM), 0.1),
        "cmp_k_w1": nrm(ks[10], (L, CMP_BLOCK * HEAD_DIM, CMP_HIDDEN), (CMP_BLOCK * HEAD_DIM) ** -0.5),
        "cmp_k_b1": nrm(ks[11], (L, CMP_HIDDEN), 0.02),
        "cmp_k_w2": nrm(ks[12], (L, CMP_HIDDEN, HEAD_DIM), CMP_HIDDEN ** -0.5),
        "cmp_k_b2": nrm(ks[13], (L, HEAD_DIM), 0.02),
        "cmp_v_w1": nrm(ks[14], (L, CMP_BLOCK * HEAD_DIM, CMP_HIDDEN), (CMP_BLOCK * HEAD_DIM) ** -0.5),
        "cmp_v_b1": nrm(ks[15], (L, CMP_HIDDEN), 0.02),
        "cmp_v_w2": nrm(ks[16], (L, CMP_HIDDEN, HEAD_DIM), CMP_HIDDEN ** -0.5),
        "cmp_v_b2": nrm(ks[17], (L, HEAD_DIM), 0.02),
        "gmlp_ln_g": gain(ks[18], (L, D_GMLP)),
        "gmlp_ln_b": nrm(ks[19], (L, D_GMLP), 0.02),
        "gmlp_ws": nrm(ks[20], (L, GMLP_GROUPS, GMLP_CHUNK, GMLP_CHUNK), GMLP_CHUNK ** -0.5),
        "gmlp_bs": 1.0 + nrm(ks[21], (L, GMLP_GROUPS, GMLP_CHUNK), 0.1),
        "out_g_nsa": gain(ks[22], (L, D_NSA)),
        "out_g_gmlp": gain(ks[23], (L, D_GMLP)),
        "w_out": nrm(ks[24], (L, D_MIX, D_MODEL), D_MIX ** -0.5),
        "g_ff": gain(ks[25], (L, D_MODEL)),
        "w_ff1": nrm(ks[26], (L, D_MODEL, D_FF), D_MODEL ** -0.5),
        "w_ff2": nrm(ks[27], (L, D_FF, D_MODEL), D_FF ** -0.5),
        "g_ple": gain(ks[28], (L, D_MODEL)),
        "w_ple_gate": nrm(ks[29], (L, D_MODEL, D_MODEL), D_MODEL ** -0.5),
        "w_ple": nrm(ks[30], (L, D_PLE, D_MODEL), D_PLE ** -0.5),
    }


def reference(x, p, g_mix, w_in, q_norm_g, kc_norm_g, ks_norm_g, kw_norm_g, cmp_pos_k, cmp_pos_v,
              cmp_k_w1, cmp_k_b1, cmp_k_w2, cmp_k_b2, cmp_v_w1, cmp_v_b1, cmp_v_w2, cmp_v_b2,
              gmlp_ln_g, gmlp_ln_b, gmlp_ws, gmlp_bs, out_g_nsa, out_g_gmlp, w_out,
              g_ff, w_ff1, w_ff2, g_ple, w_ple_gate, w_ple):
    B, T = x.shape[0], x.shape[1]
    o = COL_OFFS
    for i in range(DEPTH):
        h = rmsnorm(x, g_mix[i])
        z = h @ w_in[i]
        kv = lambda j: z[..., o[j]:o[j + 1]].reshape(B, T, N_KV, HEAD_DIM)
        q = rmsnorm(z[..., o[0]:o[1]].reshape(B, T, N_HEADS, HEAD_DIM), q_norm_g[i])
        q = q.reshape(B, T, N_KV, Q_PER_KV, HEAD_DIM)
        k_c = rmsnorm(compress(kv(1), cmp_pos_k[i], cmp_k_w1[i], cmp_k_b1[i], cmp_k_w2[i], cmp_k_b2[i]),
                      kc_norm_g[i])
        v_c = compress(kv(2), cmp_pos_v[i], cmp_v_w1[i], cmp_v_b1[i], cmp_v_w2[i], cmp_v_b2[i])
        k_s = rmsnorm(kv(3), ks_norm_g[i])
        v_s = kv(4)
        k_w = rmsnorm(kv(5), kw_norm_g[i])
        v_w = kv(6)
        gates = jax.nn.sigmoid(z[..., o[7]:o[8]]).reshape(B, T, N_KV, Q_PER_KV, 3)
        u = jax.nn.gelu(z[..., o[8]:o[9]])
        v = jax.nn.gelu(z[..., o[9]:o[10]])
        a_out = nsa_attention(q, k_c, v_c, k_s, v_s, k_w, v_w, gates)
        g_out = gmlp_mix(u, v, gmlp_ln_g[i], gmlp_ln_b[i], gmlp_ws[i], gmlp_bs[i])
        mix = jnp.concatenate([rmsnorm(a_out, out_g_nsa[i]), rmsnorm(g_out, out_g_gmlp[i])], axis=-1)
        x = x + mix @ w_out[i]
        h = rmsnorm(x, g_ff[i])
        x = x + jnp.square(jax.nn.relu(h @ w_ff1[i])) @ w_ff2[i]
        gate = jax.nn.sigmoid(rmsnorm(x, g_ple[i]) @ w_ple_gate[i])
        x = x + gate * (p[i] @ w_ple[i])
    return x
```

```cpp
#include <hip/hip_runtime.h>
#include <hip/hip_cooperative_groups.h>
#include <cstdio>
#include <cstdint>
namespace cg = cooperative_groups;
namespace pg8 {
#define PG8_LAS __attribute__((address_space(3)))
typedef unsigned short bf16_t;
typedef short bf16x8 __attribute__((ext_vector_type(8)));
typedef float f32x4 __attribute__((ext_vector_type(4)));
typedef unsigned u32x4 __attribute__((ext_vector_type(4)));
constexpr int BM = 256, BK = 64, HALF = 128, HTB = HALF * BK * 2  , STAGE_BYTES = 8 * HTB, NXCD = 8, WGM = 8;

__host__ __device__ __forceinline__ int lds_byte(int r, int c) { const int st = (r >> 4) * 2 + (c >> 5), rr = r & 15, cc = c & 31, ob = rr * 64 + cc * 2; return st * 1024 + (ob ^ (((ob >> 9) & 1) << 5)); }
__host__ __device__ __forceinline__ void stage_rc(int b, int& R, int& C) { const int st = b / 1024, sb = b % 1024, swz = sb ^ (((sb >> 9) & 1) << 5); R = (st >> 1) * 16 + swz / 64; C = (st & 1) * 32 + (swz % 64) / 2; }
__host__ __device__ __forceinline__ int perm32(int rho) { const int n = rho >> 4, i = rho & 15; return 8 * (i >> 2) + 4 * n + (i & 3); }

struct Unit { int pm, pn; };
struct Gemm { const bf16_t* A; const bf16_t* Bt; int M, N, K, lda, ldb; };

struct StaticOrder {
    int nM, nN, nwg, G, c;
    __host__ __device__ void init(int M, int N, int G_, int c_) { nM = M / BM; nN = N / BM; nwg = nM * nN; G = G_; c = c_; }
    __host__ __device__ bool next(int i, Unit& u) const {
        const long L = (long)i * G + c; if (L >= nwg) return false;
        int wgid = (int)L; { const int q = nwg / NXCD, r = nwg % NXCD, xcd = wgid % NXCD, off = wgid / NXCD; wgid = (xcd < r ? xcd * (q + 1) : r * (q + 1) + (xcd - r) * q) + off; }
        const int nig = WGM * nN, gid = wgid / nig, fm = gid * WGM, gsz = (nM - fm) < WGM ? (nM - fm) : WGM;
        u.pm = fm + ((wgid % nig) % gsz); u.pn = (wgid % nig) / gsz; return true;
    }
    __device__ __forceinline__ void a_ready(const Unit&) const {}
    __device__ __forceinline__ void done(const Unit&) const {}
};

__device__ __forceinline__ unsigned cvt_pk_bf16(float lo, float hi) { unsigned r; asm volatile("v_cvt_pk_bf16_f32 %0, %1, %2" : "=v"(r) : "v"(lo), "v"(hi)); return r; }
template <class Epi, class Sched, bool ALIGN_EPI = false, bool SP2 = false>
__device__ __forceinline__ void gemm_phase(PG8_LAS unsigned char* lds, const Gemm g, const Sched& S, const Epi& E) {
    int tid_ = threadIdx.x; asm volatile("" : "+v"(tid_));
    const int tid = tid_, wid = __builtin_amdgcn_readfirstlane(tid >> 6), lane = tid & 63, wr = wid >> 2, wc = wid & 3, fr = lane & 15, fq = lane >> 4;
    const int K = g.K, nt = K / BK;
    unsigned voffA[2], voffB[2];
#pragma unroll
    for (int i = 0; i < 2; ++i) { int R, C; stage_rc(tid * 16 + i * 8192, R, C); const int Rb = Epi::PERM ? ((R & ~31) + perm32(R & 31)) : R;
        voffA[i] = (unsigned)(R * g.lda + C) * 2u; voffB[i] = (unsigned)(Rb * g.ldb + C) * 2u; }
    const size_t kstep = (size_t)(BK * 2);
    const size_t hstepA = (size_t)HALF * g.lda * 2, hstepB = (size_t)HALF * g.ldb * 2;
    const size_t tstepA = 2 * hstepA, tstepB = 2 * hstepB;
    const unsigned ldsw = (unsigned)wid * 1024u;
    const int aoff = lds_byte(wr * 64 + fr, fq * 8), boff = lds_byte(wc * 32 + fr, fq * 8);
#define PG8_SA(b, h) (((b) * 2 + (h)) * HTB)
#define PG8_SB(b, h) ((4 + (b) * 2 + (h)) * HTB)
#define PG8_STAGE(bufoff, gbase, voff) do { _Pragma("unroll") for (int _i = 0; _i < 2; ++_i) \
        __builtin_amdgcn_global_load_lds((const unsigned*)((const char*)(gbase) + (voff)[_i]), (PG8_LAS unsigned*)(lds + (bufoff) + ldsw + _i * 8192), 16, 0, 0); } while (0)
#define PG8_LDA(dst, b, h) do { _Pragma("unroll") for (int m = 0; m < 4; ++m) _Pragma("unroll") for (int k = 0; k < 2; ++k) dst[m][k] = *(const PG8_LAS bf16x8*)(lds + PG8_SA(b, h) + aoff + m * 2048 + k * 1024); } while (0)
#define PG8_LDB(dst, b, h) do { _Pragma("unroll") for (int n = 0; n < 2; ++n) _Pragma("unroll") for (int k = 0; k < 2; ++k) dst[n][k] = *(const PG8_LAS bf16x8*)(lds + PG8_SB(b, h) + boff + n * 2048 + k * 1024); } while (0)
#define PG8_MMA(ai, bj, At, Bt) do { __builtin_amdgcn_s_setprio(1); _Pragma("unroll") for (int m = 0; m < 4; ++m) _Pragma("unroll") for (int n = 0; n < 2; ++n) _Pragma("unroll") for (int k = 0; k < 2; ++k) \
        acc[ai][bj][m][n] = __builtin_amdgcn_mfma_f32_16x16x32_bf16(Bt[n][k], At[m][k], acc[ai][bj][m][n], 0, 0, 0); __builtin_amdgcn_s_setprio(0); } while (0)
#define PG8_WAIT_V(n) asm volatile("s_waitcnt vmcnt(" #n ")" ::: "memory")
#define PG8_WAIT_L(n) asm volatile("s_waitcnt lgkmcnt(" #n ")" ::: "memory")
#define PG8_BAR __builtin_amdgcn_s_barrier()
#define PG8_SCHED __builtin_amdgcn_sched_barrier(0)
    Unit cur, nxt; int ui = 0;
    if (!S.next(0, cur)) return;
    f32x4 acc[2][2][4][2];
#pragma unroll
    for (int a = 0; a < 2; ++a)
#pragma unroll
        for (int b = 0; b < 2; ++b)
#pragma unroll
            for (int m = 0; m < 4; ++m)
#pragma unroll
                for (int n = 0; n < 2; ++n) acc[a][b][m][n] = (f32x4){0.f, 0.f, 0.f, 0.f};
    bf16x8 At[4][2], B0[2][2], B1[2][2];
    const char* cA = (const char*)g.A + (size_t)cur.pm * tstepA; const char* cB = (const char*)g.Bt + (size_t)cur.pn * tstepB;
    S.a_ready(cur);
    if constexpr (SP2) {
        PG8_STAGE(PG8_SB(0, 0), cB, voffB); PG8_STAGE(PG8_SB(0, 1), cB + hstepB, voffB); PG8_STAGE(PG8_SA(0, 0), cA, voffA); PG8_STAGE(PG8_SA(0, 1), cA + hstepA, voffA);
        if (wr == 1) PG8_BAR;
        PG8_WAIT_V(2); PG8_BAR;
        PG8_STAGE(PG8_SB(1, 0), cB + kstep, voffB); PG8_STAGE(PG8_SA(1, 0), cA + kstep, voffA); PG8_STAGE(PG8_SB(1, 1), cB + hstepB + kstep, voffB);
        PG8_WAIT_V(6); PG8_BAR;
    } else {
        PG8_STAGE(PG8_SB(0, 0), cB, voffB); PG8_STAGE(PG8_SA(0, 0), cA, voffA); PG8_STAGE(PG8_SB(0, 1), cB + hstepB, voffB); PG8_STAGE(PG8_SA(0, 1), cA + hstepA, voffA);
        if (wr == 1) PG8_BAR;
        PG8_WAIT_V(4); PG8_BAR;
        PG8_STAGE(PG8_SB(1, 0), cB + kstep, voffB); PG8_STAGE(PG8_SA(1, 0), cA + kstep, voffA); PG8_STAGE(PG8_SB(1, 1), cB + hstepB + kstep, voffB);
        PG8_WAIT_V(6); PG8_BAR;
    }
    for (;;) {
        const bool has_next = S.next(ui + 1, nxt);
        const char* nA = has_next ? (const char*)g.A + (size_t)nxt.pm * tstepA : cA; const char* nB = has_next ? (const char*)g.Bt + (size_t)nxt.pn * tstepB : cB;
        for (int t = 0; t < nt; t += 2) {
            const bool last = (t == nt - 2);
            const char* a1 = cA + (size_t)(t + 1) * kstep;
            const char* a2 = last ? nA : cA + (size_t)(t + 2) * kstep; const char* b2 = last ? nB : cB + (size_t)(t + 2) * kstep;
            const char* a3 = a2 + kstep; const char* b3 = b2 + kstep;
            if (last && has_next) S.a_ready(nxt);
            if constexpr (SP2) {
            PG8_LDB(B0, 0, 0); PG8_LDB(B1, 0, 1); PG8_SCHED; PG8_LDA(At, 0, 0); PG8_STAGE(PG8_SA(1, 1), a1 + hstepA, voffA);
            PG8_WAIT_V(8); PG8_WAIT_L(0); PG8_BAR; PG8_MMA(0, 0, At, B0); PG8_MMA(0, 1, At, B1); PG8_BAR; PG8_SCHED;
            PG8_LDA(At, 0, 1); PG8_STAGE(PG8_SB(0, 0), b2, voffB); PG8_STAGE(PG8_SB(0, 1), b2 + hstepB, voffB); PG8_STAGE(PG8_SA(0, 0), a2, voffA);
            PG8_WAIT_V(8); PG8_WAIT_L(0); PG8_BAR; PG8_MMA(1, 0, At, B0); PG8_MMA(1, 1, At, B1); PG8_BAR; PG8_SCHED;
            PG8_LDB(B0, 1, 0); PG8_LDB(B1, 1, 1); PG8_SCHED; PG8_LDA(At, 1, 0); PG8_STAGE(PG8_SA(0, 1), a2 + hstepA, voffA);
            PG8_WAIT_V(8); PG8_WAIT_L(0); PG8_BAR; PG8_MMA(0, 0, At, B0); PG8_MMA(0, 1, At, B1); PG8_BAR; PG8_SCHED;
            PG8_LDA(At, 1, 1); PG8_STAGE(PG8_SB(1, 0), b3, voffB); PG8_STAGE(PG8_SB(1, 1), b3 + hstepB, voffB); PG8_STAGE(PG8_SA(1, 0), a3, voffA);
            PG8_WAIT_V(8); PG8_WAIT_L(0); PG8_BAR; PG8_MMA(1, 0, At, B0); PG8_MMA(1, 1, At, B1); PG8_BAR; PG8_SCHED;
            } else {
            PG8_LDB(B0, 0, 0); PG8_SCHED; PG8_LDA(At, 0, 0); PG8_STAGE(PG8_SA(1, 1), a1 + hstepA, voffA);
            PG8_WAIT_L(8); PG8_BAR; PG8_WAIT_L(0); PG8_MMA(0, 0, At, B0); PG8_BAR; PG8_SCHED;
            PG8_LDB(B1, 0, 1); PG8_STAGE(PG8_SB(0, 0), b2, voffB);
            PG8_BAR; PG8_WAIT_L(0); PG8_MMA(0, 1, At, B1); PG8_BAR;
            PG8_LDA(At, 0, 1); PG8_STAGE(PG8_SA(0, 0), a2, voffA);
            PG8_BAR; PG8_WAIT_L(0); PG8_MMA(1, 0, At, B0); PG8_BAR; PG8_SCHED;
            PG8_STAGE(PG8_SB(0, 1), b2 + hstepB, voffB);
            PG8_WAIT_V(6); PG8_BAR; PG8_MMA(1, 1, At, B1); PG8_BAR;
            PG8_LDB(B0, 1, 0); PG8_SCHED; PG8_LDA(At, 1, 0); PG8_STAGE(PG8_SA(0, 1), a2 + hstepA, voffA);
            PG8_WAIT_L(8); PG8_BAR; PG8_WAIT_L(0); PG8_MMA(0, 0, At, B0); PG8_BAR; PG8_SCHED;
            PG8_LDB(B1, 1, 1); PG8_STAGE(PG8_SB(1, 0), b3, voffB);
            PG8_BAR; PG8_WAIT_L(0); PG8_MMA(0, 1, At, B1); PG8_BAR;
            PG8_LDA(At, 1, 1); PG8_STAGE(PG8_SA(1, 0), a3, voffA);
            PG8_BAR; PG8_WAIT_L(0); PG8_MMA(1, 0, At, B0); PG8_BAR; PG8_SCHED;
            PG8_STAGE(PG8_SB(1, 1), b3 + hstepB, voffB);
            PG8_WAIT_V(6); PG8_BAR; PG8_MMA(1, 1, At, B1); PG8_BAR;
            }
        }
        if constexpr (ALIGN_EPI) { if (wr == 0) PG8_BAR; }
        if constexpr (!Epi::AFTER_DRAIN) { E(acc, cur, wr, wc, fr, fq); S.done(cur); }
        if (!has_next) break;
#pragma unroll
        for (int a = 0; a < 2; ++a)
#pragma unroll
            for (int b = 0; b < 2; ++b)
#pragma unroll
                for (int m = 0; m < 4; ++m)
#pragma unroll
                    for (int n = 0; n < 2; ++n) acc[a][b][m][n] = (f32x4){0.f, 0.f, 0.f, 0.f};
        cur = nxt; cA = nA; cB = nB; ++ui;
        if constexpr (ALIGN_EPI) { if (wr == 1) PG8_BAR; }
    }
    PG8_WAIT_V(0);
    if constexpr (!ALIGN_EPI) { if (wr == 0) PG8_BAR; }
    PG8_BAR;
    if constexpr (Epi::AFTER_DRAIN) { E.fused(acc, cur, wr, wc, fr, fq, lds, wid, lane); S.done(cur); }
#undef PG8_SA
#undef PG8_SB
#undef PG8_STAGE
#undef PG8_LDA
#undef PG8_LDB
#undef PG8_MMA
#undef PG8_WAIT_V
#undef PG8_WAIT_L
#undef PG8_BAR
#undef PG8_SCHED
}
}

#define LAS __attribute__((address_space(3)))
typedef unsigned short bf16;
typedef unsigned u32x4 __attribute__((ext_vector_type(4)));
typedef unsigned u32x2 __attribute__((ext_vector_type(2)));
typedef float f32x4 __attribute__((ext_vector_type(4)));
typedef float f32x16 __attribute__((ext_vector_type(16)));
typedef short bf16x8 __attribute__((ext_vector_type(8)));

constexpr int NB = 8, NT = 4096, DM = 1024, MROWS = NB * NT, FF = 4096, DPLE = 256, NINP = 2560;
constexpr float EPS = 1e-6f;
constexpr float LOG2E = 1.4426950408889634f;
constexpr float QSCALE = 0.125f * LOG2E;
constexpr size_t MiB = (size_t)1 << 20;
constexpr size_t WS_BAR = 512 * 1024, WS_WSB = 640 * 1024;
constexpr size_t WS_BAR_ = 0;
constexpr size_t WS_B1P = 0, WS_WIN = 1 * MiB, WS_WO = 6 * MiB, WS_W1 = 8 * MiB, WS_W2 = 16 * MiB, WS_WG = 24 * MiB, WS_WP = 26 * MiB,
                 WS_WC1K = 27 * MiB, WS_WC1V = 28 * MiB, WS_RSS1 = 29 * MiB, WS_RSS2 = 31 * MiB, WS_XB = 34 * MiB, WS_PB = 98 * MiB,
                 WS_TP = 114 * MiB, WS_BIG = 178 * MiB;
constexpr size_t WS_H1 = WS_BIG, WS_ZQ = WS_BIG, WS_ZU = WS_BIG + 32 * MiB, WS_ZV = WS_BIG + 64 * MiB, WS_MIX = WS_BIG + 96 * MiB,
                 WS_KV = WS_BIG + 160 * MiB, KV_STRIDE_B = 9 * MiB, WS_GATES = WS_BIG + 214 * MiB, WS_HDNK = WS_BIG + 217 * MiB,
                 WS_HDNV = WS_BIG + 219 * MiB, WS_KC = WS_BIG + 250 * MiB, WS_VC = WS_BIG + 251 * MiB;
constexpr size_t KV_STRIDE = KV_STRIDE_B / 2;
constexpr int LDS_BYTES = 147456;

struct Args { const float* in[31]; float* out; unsigned char* ws; };
enum { I_X = 0, I_P, I_GMIX, I_WIN, I_QG, I_KCG, I_KSG, I_KWG, I_POSK, I_POSV, I_CKW1, I_CKB1, I_CKW2, I_CKB2, I_CVW1, I_CVB1, I_CVW2, I_CVB2,
       I_LNG, I_LNB, I_GWS, I_GBS, I_OGN, I_OGG, I_WOUT, I_GFF, I_WFF1, I_WFF2, I_GPLE, I_WPG, I_WPLE };

__device__ __forceinline__ unsigned f2bf(float f) { unsigned u = __builtin_bit_cast(unsigned, f); return (u + 0x7fffu + ((u >> 16) & 1u)) >> 16; }
typedef __bf16 bf16x2_t __attribute__((ext_vector_type(2))); typedef float f32x2_t __attribute__((ext_vector_type(2)));
__device__ __forceinline__ unsigned pk2(float lo, float hi) { return f2bf(lo) | (f2bf(hi) << 16); }
__device__ __forceinline__ unsigned pk2_hw(float lo, float hi) { f32x2_t v = {lo, hi}; bf16x2_t b = __builtin_convertvector(v, bf16x2_t); return __builtin_bit_cast(unsigned, b); }
__device__ __forceinline__ float bflo(unsigned u) { return __builtin_bit_cast(float, u << 16); }
__device__ __forceinline__ float bfhi(unsigned u) { return __builtin_bit_cast(float, u & 0xffff0000u); }
__device__ __forceinline__ float wave_sum(float v) {
    v += __builtin_bit_cast(float, __builtin_amdgcn_update_dpp(0, __builtin_bit_cast(int, v), 0xB1, 0xf, 0xf, false));
    v += __builtin_bit_cast(float, __builtin_amdgcn_update_dpp(0, __builtin_bit_cast(int, v), 0x4E, 0xf, 0xf, false));
    v += __builtin_bit_cast(float, __builtin_amdgcn_update_dpp(0, __builtin_bit_cast(int, v), 0x141, 0xf, 0xf, false));
    v += __builtin_bit_cast(float, __builtin_amdgcn_update_dpp(0, __builtin_bit_cast(int, v), 0x140, 0xf, 0xf, false));
    v += __builtin_bit_cast(float, __builtin_amdgcn_update_dpp(0, __builtin_bit_cast(int, v), 0x142, 0xa, 0xf, false));
    v += __builtin_bit_cast(float, __builtin_amdgcn_update_dpp(0, __builtin_bit_cast(int, v), 0x143, 0xc, 0xf, false));
    return __builtin_bit_cast(float, __builtin_amdgcn_readlane(__builtin_bit_cast(int, v), 63));
}
__device__ __forceinline__ float gelu_tanh(float x) {
    const float u = x + 0.044715f * x * x * x;
    const float e = __builtin_amdgcn_exp2f(-2.3022082f * u);
    return x * __builtin_amdgcn_rcpf(1.0f + e);
}
__device__ __forceinline__ float sigmoidf_(float x) { return __builtin_amdgcn_rcpf(1.0f + __builtin_amdgcn_exp2f(-LOG2E * x)); }
__device__ __forceinline__ u32x4 pack8(f32x4 a, f32x4 b) { u32x4 w; w.x = pk2(a[0], a[1]); w.y = pk2(a[2], a[3]); w.z = pk2(b[0], b[1]); w.w = pk2(b[2], b[3]); return w; }
__device__ __forceinline__ u32x4 pack8_hw(f32x4 a, f32x4 b) { u32x4 w; w.x = pg8::cvt_pk_bf16(a[0], a[1]); w.y = pg8::cvt_pk_bf16(a[2], a[3]); w.z = pg8::cvt_pk_bf16(b[0], b[1]); w.w = pg8::cvt_pk_bf16(b[2], b[3]); return w; }

template <class F> struct EpiRow {
    static constexpr bool PERM = true, AFTER_DRAIN = false;
    F f;
    __device__ __forceinline__ void operator()(const pg8::f32x4 (&acc)[2][2][4][2], const pg8::Unit& u, int wr, int wc, int fr, int fq) const {
        const int c0 = u.pn * 256 + wc * 32 + 8 * fq;
#pragma unroll
        for (int ai = 0; ai < 2; ++ai)
#pragma unroll
            for (int m = 0; m < 4; ++m) {
                const int row = u.pm * 256 + ai * 128 + wr * 64 + m * 16 + fr;
                f(row, c0, u.pn * 4 + wc, acc[ai][0][m][0], acc[ai][0][m][1], acc[ai][1][m][0], acc[ai][1][m][1]);
            }
    }
};

template <class F> struct EpiRowP {
    static constexpr bool PERM = true, AFTER_DRAIN = false;
    F f;
    __device__ __forceinline__ void operator()(const pg8::f32x4 (&acc)[2][2][4][2], const pg8::Unit& u, int wr, int wc, int fr, int fq) const {
        const int c0 = u.pn * 256 + wc * 32 + 8 * fq, rbase = u.pm * 256 + wr * 64 + fr;
        typename F::Pre nx = f.pre(rbase, c0);
#pragma unroll
        for (int idx = 0; idx < 8; ++idx) {
            const int ai = idx >> 2, m = idx & 3, row = rbase + ai * 128 + m * 16;
            const typename F::Pre cur = nx;
            if (idx < 7) nx = f.pre(rbase + ((idx + 1) >> 2) * 128 + ((idx + 1) & 3) * 16, c0);
            f(row, c0, u.pn * 4 + wc, acc[ai][0][m][0], acc[ai][0][m][1], acc[ai][1][m][0], acc[ai][1][m][1], cur);
        }
    }
};
struct Pre4 { f32x4 v[4]; };
__device__ __forceinline__ float rinv_from(const Pre4& p) {
    const float s = ((p.v[0][0] + p.v[0][1]) + (p.v[0][2] + p.v[0][3])) + ((p.v[1][0] + p.v[1][1]) + (p.v[1][2] + p.v[1][3])) + ((p.v[2][0] + p.v[2][1]) + (p.v[2][2] + p.v[2][3])) + ((p.v[3][0] + p.v[3][1]) + (p.v[3][2] + p.v[3][3]));
    return __builtin_amdgcn_rsqf(s * (1.0f / DM) + EPS);
}
struct FIn {
    bf16* zq; bf16* kv; bf16* zu; bf16* zv; float* gates;
    __device__ __forceinline__ void one(int row, int col, f32x4 v0, f32x4 v1) const {
        if (col < 512) { *(u32x4*)(zq + (size_t)row * 512 + col) = pack8_hw(v0, v1); }
        else if (col < 1280) { const int cc = col - 512, seg = cc >> 7, w = cc & 127, g = w >> 6, d = w & 63, b = row >> 12, t = row & 4095;
            if (seg == 3 || seg == 5) {
                bf16* vt = kv + (size_t)seg * KV_STRIDE + ((size_t)(b * 2 + g) * 4096 + (t & ~63)) * 64 + (size_t)d * 64 + (t & 63);
                const u32x4 pk = pack8_hw(v0, v1);
                vt[0 * 64] = (bf16)(pk.x & 0xffff); vt[1 * 64] = (bf16)(pk.x >> 16); vt[2 * 64] = (bf16)(pk.y & 0xffff); vt[3 * 64] = (bf16)(pk.y >> 16);
                vt[4 * 64] = (bf16)(pk.z & 0xffff); vt[5 * 64] = (bf16)(pk.z >> 16); vt[6 * 64] = (bf16)(pk.w & 0xffff); vt[7 * 64] = (bf16)(pk.w >> 16);
            } else
            *(u32x4*)(kv + (size_t)seg * KV_STRIDE + (((size_t)(b * 2 + g) * 4096 + t) * 64 + d)) = pack8_hw(v0, v1); }
        else if (col < 2304) { const int cc = col - 1280;
#pragma unroll
            for (int i = 0; i < 4; ++i) { v0[i] = gelu_tanh(v0[i]); v1[i] = gelu_tanh(v1[i]); }
            bf16* dst = cc < 512 ? zu + (size_t)row * 512 + cc : zv + (size_t)row * 512 + (cc - 512);
            *(u32x4*)dst = pack8_hw(v0, v1); }
        else if (col < 2328) {
#pragma unroll
            for (int i = 0; i < 4; ++i) { v0[i] = sigmoidf_(v0[i]); v1[i] = sigmoidf_(v1[i]); }
            float* dst = gates + (size_t)row * 24 + (col - 2304);
            *(f32x4*)dst = v0; *(f32x4*)(dst + 4) = v1; }
    }
    __device__ __forceinline__ void operator()(int row, int c0, int, f32x4 a0, f32x4 a1, f32x4 b0, f32x4 b1) const { one(row, c0, a0, a1); one(row, c0 + 128, b0, b1); }
};
struct FPlain { bf16* O; int ldc;
    __device__ __forceinline__ void operator()(int row, int c0, int, f32x4 a0, f32x4 a1, f32x4 b0, f32x4 b1) const {
        bf16* p = O + (size_t)row * ldc + c0; *(u32x4*)p = pack8(a0, a1); *(u32x4*)(p + 128) = pack8(b0, b1); }
};
struct FPart { float* O;
    __device__ __forceinline__ void operator()(int row, int c0, int, f32x4 a0, f32x4 a1, f32x4 b0, f32x4 b1) const {
        float* p = O + (size_t)row * 256 + c0; *(f32x4*)p = a0; *(f32x4*)(p + 4) = a1; *(f32x4*)(p + 128) = b0; *(f32x4*)(p + 132) = b1; }
};
struct FCmp { bf16* O; const float* b1p;
    __device__ __forceinline__ void operator()(int row, int c0, int, f32x4 a0, f32x4 a1, f32x4 b0, f32x4 b1) const {
        const f32x4 ba0 = *(const f32x4*)(b1p + c0), ba1 = *(const f32x4*)(b1p + c0 + 4), bb0 = *(const f32x4*)(b1p + c0 + 128), bb1 = *(const f32x4*)(b1p + c0 + 132);
#pragma unroll
        for (int i = 0; i < 4; ++i) { a0[i] = gelu_tanh(a0[i] + ba0[i]); a1[i] = gelu_tanh(a1[i] + ba1[i]); b0[i] = gelu_tanh(b0[i] + bb0[i]); b1[i] = gelu_tanh(b1[i] + bb1[i]); }
        bf16* p = O + (size_t)row * 256 + c0; *(u32x4*)p = pack8(a0, a1); *(u32x4*)(p + 128) = pack8(b0, b1); }
};
__device__ __forceinline__ float sumsq8(f32x4 a, f32x4 b) { return (a[0] * a[0] + a[1] * a[1]) + (a[2] * a[2] + a[3] * a[3]) + (b[0] * b[0] + b[1] * b[1]) + (b[2] * b[2] + b[3] * b[3]); }
struct FResA {
    const float* xi; bf16* xb; float* rss;
    typedef Pre4 Pre;
    __device__ __forceinline__ Pre pre(int row, int c0) const { const float* xp = xi + (size_t)row * DM + c0; Pre p; p.v[0] = *(const f32x4*)xp; p.v[1] = *(const f32x4*)(xp + 4); p.v[2] = *(const f32x4*)(xp + 128); p.v[3] = *(const f32x4*)(xp + 132); return p; }
    __device__ __forceinline__ void operator()(int row, int c0, int slot, f32x4 a0, f32x4 a1, f32x4 b0, f32x4 b1, const Pre& p) const {
        a0 += p.v[0]; a1 += p.v[1]; b0 += p.v[2]; b1 += p.v[3];
        bf16* bp = xb + (size_t)row * DM + c0; *(u32x4*)bp = pack8_hw(a0, a1); *(u32x4*)(bp + 128) = pack8_hw(b0, b1);
        float s = sumsq8(a0, a1) + sumsq8(b0, b1);
        s += __shfl_xor(s, 16); s += __shfl_xor(s, 32);
        if ((threadIdx.x & 63) < 16) rss[(size_t)row * 16 + slot] = s;
    }
};
struct PreB { u32x4 a, b; };
struct FResB {
    float* xo; bf16* xb; float* rss;
    typedef PreB Pre;
    __device__ __forceinline__ Pre pre(int row, int c0) const { const bf16* xp = xb + (size_t)row * DM + c0; Pre p; p.a = *(const u32x4*)xp; p.b = *(const u32x4*)(xp + 128); return p; }
    __device__ __forceinline__ void operator()(int row, int c0, int slot, f32x4 a0, f32x4 a1, f32x4 b0, f32x4 b1, const Pre& p) const {
        a0[0] += bflo(p.a.x); a0[1] += bfhi(p.a.x); a0[2] += bflo(p.a.y); a0[3] += bfhi(p.a.y); a1[0] += bflo(p.a.z); a1[1] += bfhi(p.a.z); a1[2] += bflo(p.a.w); a1[3] += bfhi(p.a.w);
        b0[0] += bflo(p.b.x); b0[1] += bfhi(p.b.x); b0[2] += bflo(p.b.y); b0[3] += bfhi(p.b.y); b1[0] += bflo(p.b.z); b1[1] += bfhi(p.b.z); b1[2] += bflo(p.b.w); b1[3] += bfhi(p.b.w);
        float* op = xo + (size_t)row * DM + c0;
        *(f32x4*)op = a0; *(f32x4*)(op + 4) = a1; *(f32x4*)(op + 128) = b0; *(f32x4*)(op + 132) = b1;
        bf16* bp = xb + (size_t)row * DM + c0; *(u32x4*)bp = pack8_hw(a0, a1); *(u32x4*)(bp + 128) = pack8_hw(b0, b1);
        float s = sumsq8(a0, a1) + sumsq8(b0, b1);
        s += __shfl_xor(s, 16); s += __shfl_xor(s, 32);
        if ((threadIdx.x & 63) < 16) rss[(size_t)row * 16 + slot] = s;
    }
};
__device__ __forceinline__ float row_rinv(const float* rss, int row) {
    const f32x4* p = (const f32x4*)(rss + (size_t)row * 16);
    const f32x4 a = p[0], b = p[1], c = p[2], d = p[3];
    const float s = ((a[0] + a[1]) + (a[2] + a[3])) + ((b[0] + b[1]) + (b[2] + b[3])) + ((c[0] + c[1]) + (c[2] + c[3])) + ((d[0] + d[1]) + (d[2] + d[3]));
    return __builtin_amdgcn_rsqf(s * (1.0f / DM) + EPS);
}
struct FFF1 { bf16* H; const float* rss;
    typedef Pre4 Pre;
    __device__ __forceinline__ Pre pre(int row, int) const { const f32x4* q = (const f32x4*)(rss + (size_t)row * 16); Pre p; p.v[0] = q[0]; p.v[1] = q[1]; p.v[2] = q[2]; p.v[3] = q[3]; return p; }
    __device__ __forceinline__ void operator()(int row, int c0, int, f32x4 a0, f32x4 a1, f32x4 b0, f32x4 b1, const Pre& pp) const {
        const float r = rinv_from(pp);
#pragma unroll
        for (int i = 0; i < 4; ++i) { float t;
            t = fmaxf(a0[i] * r, 0.f); a0[i] = t * t; t = fmaxf(a1[i] * r, 0.f); a1[i] = t * t;
            t = fmaxf(b0[i] * r, 0.f); b0[i] = t * t; t = fmaxf(b1[i] * r, 0.f); b1[i] = t * t; }
        bf16* p = H + (size_t)row * FF + c0; *(u32x4*)p = pack8_hw(a0, a1); *(u32x4*)(p + 128) = pack8_hw(b0, b1); }
};
struct FGate { float* xo; const bf16* tp; const float* rss;
    __device__ __forceinline__ void operator()(int row, int c0, int, f32x4 a0, f32x4 a1, f32x4 b0, f32x4 b1) const {
        const float r = row_rinv(rss, row);
        float* op = xo + (size_t)row * DM + c0;
        const u32x4 ta = *(const u32x4*)(tp + (size_t)row * DM + c0), tb = *(const u32x4*)(tp + (size_t)row * DM + c0 + 128);
        f32x4 x0 = *(f32x4*)op, x1 = *(f32x4*)(op + 4), y0 = *(f32x4*)(op + 128), y1 = *(f32x4*)(op + 132);
        x0[0] += sigmoidf_(a0[0] * r) * bflo(ta.x); x0[1] += sigmoidf_(a0[1] * r) * bfhi(ta.x); x0[2] += sigmoidf_(a0[2] * r) * bflo(ta.y); x0[3] += sigmoidf_(a0[3] * r) * bfhi(ta.y);
        x1[0] += sigmoidf_(a1[0] * r) * bflo(ta.z); x1[1] += sigmoidf_(a1[1] * r) * bfhi(ta.z); x1[2] += sigmoidf_(a1[2] * r) * bflo(ta.w); x1[3] += sigmoidf_(a1[3] * r) * bfhi(ta.w);
        y0[0] += sigmoidf_(b0[0] * r) * bflo(tb.x); y0[1] += sigmoidf_(b0[1] * r) * bfhi(tb.x); y0[2] += sigmoidf_(b0[2] * r) * bflo(tb.y); y0[3] += sigmoidf_(b0[3] * r) * bfhi(tb.y);
        y1[0] += sigmoidf_(b1[0] * r) * bflo(tb.z); y1[1] += sigmoidf_(b1[1] * r) * bfhi(tb.z); y1[2] += sigmoidf_(b1[2] * r) * bflo(tb.w); y1[3] += sigmoidf_(b1[3] * r) * bfhi(tb.w);
        *(f32x4*)op = x0; *(f32x4*)(op + 4) = x1; *(f32x4*)(op + 128) = y0; *(f32x4*)(op + 132) = y1;
    }
};
struct TpDeal {
    int bx, G;
    __device__ __forceinline__ bool next(int i, pg8::Unit& u) const {
        int k;
        if (G == 256) { if (bx < 128) { if (i != 0) return false; k = bx; } else { if (i >= 3) return false; k = 128 + (bx - 128) * 3 + i; } }
        else { k = bx + i * G; if (k >= 512) return false; }
        u.pm = k >> 2; u.pn = k & 3; return true;
    }
    __device__ __forceinline__ void a_ready(const pg8::Unit&) const {}
    __device__ __forceinline__ void done(const pg8::Unit&) const {}
};
struct OneUnit {
    int pm;
    __device__ __forceinline__ bool next(int i, pg8::Unit& u) const { if (i != 0 || pm < 0) return false; u.pm = pm; u.pn = 0; return true; }
    __device__ __forceinline__ void a_ready(const pg8::Unit&) const {}
    __device__ __forceinline__ void done(const pg8::Unit&) const {}
};

__device__ __forceinline__ void tr_item(const float* W, int ldw, int k0, int n0, bf16* WT, int ldt, int row0, const float* gain, LAS float* scr, int lane) {
#pragma unroll 8
    for (int i = 0; i < 32; ++i) { const int kk = 2 * i + (lane >> 5); float v = W[(size_t)(k0 + kk) * ldw + n0 + (lane & 31)]; if (gain) v *= gain[k0 + kk]; scr[kk * 33 + (lane & 31)] = v; }
    asm volatile("s_waitcnt lgkmcnt(0)" ::: "memory");
    const int c = lane & 7;
#pragma unroll
    for (int j = 0; j < 4; ++j) { const int n = (lane >> 3) + 8 * j; const LAS float* s = scr + (8 * c) * 33 + n;
        u32x4 o; o.x = pk2(s[0 * 33], s[1 * 33]); o.y = pk2(s[2 * 33], s[3 * 33]); o.z = pk2(s[4 * 33], s[5 * 33]); o.w = pk2(s[6 * 33], s[7 * 33]);
        *(u32x4*)(WT + (size_t)(row0 + n) * ldt + k0 + 8 * c) = o; }
    asm volatile("s_waitcnt lgkmcnt(0)" ::: "memory");
}

namespace att {
constexpr int KROW = 144, VROW = 136, KSZ = 64 * KROW, VSZ = 64 * VROW, BUFSZ = KSZ + VSZ;
constexpr int OFF_K = 0, OFF_V = KSZ, OFF_IMP = 2 * BUFSZ, IMPW = 8 * 65 * 4, OFF_RS = OFF_IMP + 8 * IMPW, OFF_UM = OFF_RS + 512, OFF_TL = OFF_UM + 64, OFF_TN = OFF_TL + 512, OFF_Q = OFF_TN + 64, OFF_STG = OFF_Q + 8 * 4096, ATT_END = OFF_STG + 8 * 4096;
static_assert(ATT_END <= 147456 && OFF_Q % 16 == 0 && OFF_IMP % 16 == 0 && BUFSZ % 16 == 0, "attention LDS");
}
#define XB_TMO      128
#define XB_XCNT(j)  (256  + 64 * (j))
#define XB_XSUB(j)  (1280 + 64 * (j))
#define XB_XGEN(j)  (2304 + 64 * (j))
#define XB_TOP      3328
#define XB_TOPGEN   3392
#define XCD_BAR_WORDS 3456
#define XB_SPIN_CAP (1u << 22)

__device__ __forceinline__ unsigned xb_ld(unsigned* p)              { return __hip_atomic_load(p, __ATOMIC_RELAXED, __HIP_MEMORY_SCOPE_AGENT); }
__device__ __forceinline__ unsigned xb_add(unsigned* p, unsigned v) { return __hip_atomic_fetch_add(p, v, __ATOMIC_RELAXED, __HIP_MEMORY_SCOPE_AGENT); }
__device__ __forceinline__ unsigned xb_xcc_id() { return (unsigned)__builtin_amdgcn_s_getreg((3 << 11) | 20) & 0xFu; }
#define XB_SPIN(cond, bar) do { unsigned _sp = 0; while (cond) { __builtin_amdgcn_s_sleep(1); \
    if ((++_sp & 255u) == 0u) { if (xb_ld(&(bar)[XB_TMO])) break; if (_sp > XB_SPIN_CAP) { atomicAdd(&(bar)[XB_TMO], 1u); break; } } } } while (0)

struct XcdBarrier {
    unsigned* bar; unsigned x;
    volatile LAS unsigned* st;
};

__device__ __forceinline__ XcdBarrier xcd_barrier_post(unsigned* bar, volatile LAS unsigned* st) {
    XcdBarrier b; b.bar = bar; b.x = xb_xcc_id(); b.st = st;
    if (threadIdx.x == 0) (void)xb_add(&bar[XB_XCNT(b.x)], 1u);
    return b;
}
__device__ __forceinline__ void xcd_barrier_complete(unsigned* bar, unsigned x, unsigned& nloc, unsigned& nx) {
    const unsigned G = gridDim.x * gridDim.y * gridDim.z;
    unsigned sum, cnt, mine, sp = 0u;
    for (;;) {
        sum = 0u; cnt = 0u; mine = 0u;
#pragma unroll
        for (unsigned j = 0; j < 16; ++j) { const unsigned c = xb_ld(&bar[XB_XCNT(j)]); sum += c; cnt += (c > 0u) ? 1u : 0u; mine = (j == x) ? c : mine; }
        if (sum == G) break;
        __builtin_amdgcn_s_sleep(1);
        if ((++sp & 255u) == 0u) { if (xb_ld(&bar[XB_TMO])) break; if (sp > XB_SPIN_CAP) { atomicAdd(&bar[XB_TMO], 1u); break; } }
    }
    nloc = mine > 0u ? mine : 1u; nx = cnt > 0u ? cnt : 1u;
}

__device__ __forceinline__ void xcd_barrier(const XcdBarrier& b) {
    asm volatile("s_waitcnt vmcnt(0)" ::: "memory");
    __syncthreads();
    if (threadIdx.x == 0) {
        unsigned* bar = b.bar;
        __builtin_amdgcn_s_waitcnt(0);
        unsigned nloc = b.st[0], nx = b.st[1];
        if (nloc == 0u) { xcd_barrier_complete(bar, b.x, nloc, nx); b.st[0] = nloc; b.st[1] = nx; }
        const unsigned old = xb_add(&bar[XB_XSUB(b.x)], 1u);
        const unsigned gen = old / nloc;
        if (old + 1u == (gen + 1u) * nloc) {
            __builtin_amdgcn_fence(__ATOMIC_RELEASE, "agent");
            asm volatile("s_waitcnt vmcnt(0)" ::: "memory");
            const unsigned og = xb_add(&bar[XB_TOP], 1u);
            const unsigned tg = og / nx;
            if (og + 1u == (tg + 1u) * nx) xb_add(&bar[XB_TOPGEN], 1u);
            else XB_SPIN(xb_ld(&bar[XB_TOPGEN]) == tg, bar);
            __builtin_amdgcn_fence(__ATOMIC_ACQUIRE, "agent");
            xb_add(&bar[XB_XGEN(b.x)], 1u);
            asm volatile("s_waitcnt vmcnt(0)" ::: "memory");
        } else {
            XB_SPIN(xb_ld(&bar[XB_XGEN(b.x)]) == gen, bar);
            __builtin_amdgcn_fence(__ATOMIC_ACQUIRE, "agent");
            asm volatile("s_waitcnt vmcnt(0)" ::: "memory");
        }
    }
    __syncthreads();
}

namespace att {
#define NEG_INF (-__builtin_inff())
#define SBAR_() __builtin_amdgcn_sched_barrier(0)
__device__ __forceinline__ float rowmax32(const f32x16 (&s)[2]) {
    float mx = s[0][0];
#pragma unroll
    for (int kb = 0; kb < 2; ++kb)
#pragma unroll
        for (int i = 0; i < 16; ++i) mx = fmaxf(mx, s[kb][i]);
    return fmaxf(mx, __shfl_xor(mx, 32));
}
typedef float f32x2v __attribute__((ext_vector_type(2)));
__device__ __forceinline__ float exp_sub_sum(f32x16 (&s)[2], float c) {
    const f32x2v cc = {c, c}; f32x2v acc = {0.f, 0.f};
#pragma unroll
    for (int kb = 0; kb < 2; ++kb)
#pragma unroll
        for (int i = 0; i < 16; i += 2) {
            f32x2v d = {s[kb][i], s[kb][i + 1]}; d = d - cc;
            f32x2v p; p.x = __builtin_amdgcn_exp2f(d.x); p.y = __builtin_amdgcn_exp2f(d.y);
            s[kb][i] = p.x; s[kb][i + 1] = p.y; acc = acc + p;
        }
    return acc.x + acc.y;
}
__device__ __forceinline__ void exp_sub_scale(f32x16 (&s)[2], float c, float sc) {
    const f32x2v cc = {c, c}, ss = {sc, sc};
#pragma unroll
    for (int kb = 0; kb < 2; ++kb)
#pragma unroll
        for (int i = 0; i < 16; i += 2) {
            f32x2v d = {s[kb][i], s[kb][i + 1]}; d = d - cc;
            f32x2v p; p.x = __builtin_amdgcn_exp2f(d.x); p.y = __builtin_amdgcn_exp2f(d.y); p = p * ss;
            s[kb][i] = p.x; s[kb][i + 1] = p.y;
        }
}
__device__ __forceinline__ void stats_update(f32x16 (&s)[2], float& m, float& l, float base) {
    const float mx = rowmax32(s) + base, mn = fmaxf(m, mx), mu = (mn == NEG_INF) ? 0.f : mn;
    const float alpha = __builtin_amdgcn_exp2f(m - mu), c = mu - base;
    const float sum = exp_sub_sum(s, c);
    l = l * alpha + sum; m = mn;
}
template <int MUL, bool CAUSAL, bool LOWER>
__device__ __forceinline__ void scores(f32x16 (&s)[2], const bf16x8 qx, const LAS unsigned char* qL, const LAS unsigned char* Kg, int l32, int hi, int limHi, int limLo) {
    bf16x8 q[4];
#pragma unroll
    for (int ks = 0; ks < 4; ++ks) q[ks] = *(const LAS bf16x8*)(qL + ks * 1024);
    __builtin_amdgcn_s_setprio(1);
#pragma unroll
    for (int kb = 0; kb < 2; ++kb) {
        f32x16 a;
        {
            const unsigned kl = (hi == 0) ? (unsigned)__builtin_bit_cast(unsigned short, (__bf16)(float)(kb * 32 + l32)) * 0x10001u : 0u;
            u32x4 kw; kw.x = kl; kw.y = 0u; kw.z = 0u; kw.w = 0u;
            f32x16 z;
#pragma unroll
            for (int i = 0; i < 16; ++i) z[i] = 0.f;
            a = __builtin_amdgcn_mfma_f32_32x32x16_bf16(__builtin_bit_cast(bf16x8, kw), qx, z, 0, 0, 0);
        }
#pragma unroll
        for (int ks = 0; ks < 4; ++ks) {
            const bf16x8 kf = *(const LAS bf16x8*)(Kg + (kb * 32 + l32) * KROW + ks * 32 + hi * 16);
            a = __builtin_amdgcn_mfma_f32_32x32x16_bf16(kf, q[ks], a, 0, 0, 0);
        }
        if (CAUSAL || LOWER) {
#pragma unroll
            for (int i = 0; i < 16; ++i) {
                const int ci = kb * 32 + (i & 3) + 8 * (i >> 2);
                if (CAUSAL) { if (ci * MUL > limHi) a[i] = NEG_INF; }
                if (LOWER) { if (ci <= limLo) a[i] = NEG_INF; }
            }
        }
        s[kb] = a;
    }
    __builtin_amdgcn_s_setprio(0);
}
__device__ __forceinline__ bf16x8 make_qx(float slope, int hi) {
    const __bf16 h = (__bf16)slope; const __bf16 lo = (__bf16)(slope - (float)h);
    const unsigned v = (unsigned)__builtin_bit_cast(unsigned short, h) | ((unsigned)__builtin_bit_cast(unsigned short, lo) << 16);
    u32x4 w; w.x = (hi == 0) ? v : 0u; w.y = 0u; w.z = 0u; w.w = 0u;
    return __builtin_bit_cast(bf16x8, w);
}
__device__ __forceinline__ void online(f32x16 (&s)[2], f32x16 (&o)[2], float& m, float& l, float base) {
    const float mx = rowmax32(s) + base, mn = fmaxf(m, mx), mu = (mn == NEG_INF) ? 0.f : mn;
    const float alpha = __builtin_amdgcn_exp2f(m - mu), c = mu - base;
    const float sum = exp_sub_sum(s, c);
    l = l * alpha + sum; m = mn;
    if (__builtin_amdgcn_ballot_w64(alpha != 1.0f) != 0ull) {
#pragma unroll
        for (int db = 0; db < 2; ++db)
#pragma unroll
            for (int i = 0; i < 16; ++i) o[db][i] *= alpha;
    }
}
__device__ __forceinline__ void pack_p(bf16x8 (&pk)[4], const f32x16 (&s)[2]) {
#pragma unroll
    for (int kk = 0; kk < 4; ++kk) {
        const int kb = kk >> 1, i0 = (kk & 1) * 8;
        u32x4 w; w.x = pk2_hw(s[kb][i0], s[kb][i0 + 1]); w.y = pk2_hw(s[kb][i0 + 2], s[kb][i0 + 3]); w.z = pk2_hw(s[kb][i0 + 4], s[kb][i0 + 5]); w.w = pk2_hw(s[kb][i0 + 6], s[kb][i0 + 7]);
        pk[kk] = __builtin_bit_cast(bf16x8, w);
    }
}
__device__ __forceinline__ void pv(f32x16 (&o)[2], const bf16x8 (&pk)[4], const LAS unsigned char* Vg, int l32, int hi) {
    __builtin_amdgcn_s_setprio(1);
#pragma unroll
    for (int db = 0; db < 2; ++db)
#pragma unroll
        for (int kk = 0; kk < 4; ++kk) {
            const LAS unsigned char* p = Vg + (db * 32 + l32) * VROW + (kk * 16 + hi * 4) * 2;
            const u32x2 lo = *(const LAS u32x2*)p, hh = *(const LAS u32x2*)(p + 16);
            u32x4 w; w.x = lo.x; w.y = lo.y; w.z = hh.x; w.w = hh.y;
            const bf16x8 vf = __builtin_bit_cast(bf16x8, w);
            o[db] = __builtin_amdgcn_mfma_f32_32x32x16_bf16(vf, pk[kk], o[db], 0, 0, 0);
        }
    __builtin_amdgcn_s_setprio(0);
}

__device__ __forceinline__ void attn_pass(LAS unsigned char* lds, int b, int qb, int g, const float* qng, const bf16* zq, const bf16* kvb, const bf16* kc, const bf16* vc, const float* gates, bf16* mix) {
    int tid_ = threadIdx.x; asm volatile("" : "+v"(tid_));
    const int tid = tid_, lane = tid & 63, w = __builtin_amdgcn_readfirstlane(tid >> 6), l32_ = lane & 31, hi_ = lane >> 5, qi = lane & 7, hh = l32_ >> 3;
    const int q0 = qb * 64, t = q0 + 8 * w + qi, row = b * 4096 + t, head = g * 4 + hh;
    const size_t gb = (size_t)(b * 2 + g);
    const bf16* ksb = kvb + 2 * KV_STRIDE + gb * 4096 * 64; const bf16* vsb = kvb + 3 * KV_STRIDE + gb * 4096 * 64;
    const bf16* kwb = kvb + 4 * KV_STRIDE + gb * 4096 * 64; const bf16* vwb = kvb + 5 * KV_STRIDE + gb * 4096 * 64;
    const bf16* kcb = kc + gb * 256 * 64; const bf16* vcb = vc + gb * 256 * 64;
    LAS int* TL = (LAS int*)(lds + OFF_TL); LAS int* TN = (LAS int*)(lds + OFF_TN); LAS unsigned* UM = (LAS unsigned*)(lds + OFF_UM); LAS float* SS = (LAS float*)(lds + OFF_RS);
    LAS float* impw = (LAS float*)(lds + OFF_IMP + w * IMPW);
    const int ntc = min(4, (((q0 + 32) >> 4) >> 6) + 1);
    LAS unsigned char* qW_ = lds + OFF_Q + w * 4096 + lane * 16;
    {
        const bf16* qp = zq + (size_t)row * 512 + head * 64 + hi_ * 8;
        u32x4 qv[4]; float ssq = 0.f;
#pragma unroll
        for (int ks = 0; ks < 4; ++ks) { qv[ks] = *(const u32x4*)(qp + ks * 16);
            const float f0 = bflo(qv[ks].x), f1 = bfhi(qv[ks].x), f2 = bflo(qv[ks].y), f3 = bfhi(qv[ks].y), f4 = bflo(qv[ks].z), f5 = bfhi(qv[ks].z), f6 = bflo(qv[ks].w), f7 = bfhi(qv[ks].w);
            ssq += ((f0 * f0 + f1 * f1) + (f2 * f2 + f3 * f3)) + ((f4 * f4 + f5 * f5) + (f6 * f6 + f7 * f7)); }
        ssq += __shfl_xor(ssq, 32);
        const float rq = __builtin_amdgcn_rsqf(ssq * (1.0f / 64.0f) + EPS) * QSCALE;
#pragma unroll
        for (int ks = 0; ks < 4; ++ks) {
            const f32x4 g0 = *(const f32x4*)(qng + ks * 16 + hi_ * 8), g1 = *(const f32x4*)(qng + ks * 16 + hi_ * 8 + 4);
            u32x4 wv;
            wv.x = pk2_hw(bflo(qv[ks].x) * rq * g0[0], bfhi(qv[ks].x) * rq * g0[1]); wv.y = pk2_hw(bflo(qv[ks].y) * rq * g0[2], bfhi(qv[ks].y) * rq * g0[3]);
            wv.z = pk2_hw(bflo(qv[ks].z) * rq * g1[0], bfhi(qv[ks].z) * rq * g1[1]); wv.w = pk2_hw(bflo(qv[ks].w) * rq * g1[2], bfhi(qv[ks].w) * rq * g1[3]);
            *(LAS u32x4*)(qW_ + ks * 1024) = wv;
        }
    }
    const float slope2 = LOG2E / (float)(2 << head);
    if (tid == 0) { int n = 0; for (int j = 0; j < ntc; ++j) TL[n++] = j; for (int j = 0; j < ntc; ++j) TL[n++] = (1 << 8) | j;
        const int j0 = qb >= 8 ? qb - 8 : 0; for (int jw = qb; jw >= j0; --jw) TL[n++] = (4 << 8) | jw; TN[0] = n; }
    __syncthreads();
    f32x16 o[2]; bf16x8 qx;
#pragma unroll
    for (int a = 0; a < 2; ++a)
#pragma unroll
        for (int i = 0; i < 16; ++i) o[a][i] = 0.f;
    qx = make_qx(16.f * slope2, hi_);
    float m = NEG_INF, l = 0.f, mc = 0.f, ilc = 0.f;
    LAS unsigned char* stg = lds + OFF_STG + w * 4096 + lane * 16;
    unsigned sel_lo = 0xffffffffu, sel_hi = 0xffffffffu, un_lo = 0xffffffffu, un_hi = 0xffffffffu;
    const int skey = tid >> 3, spart = tid & 7, soff = skey * 64 + spart * 8;
    u32x4 pfk, pfv;
#define ATT_ISSUE(code) do { const int _k = (code) >> 8, _j = (code) & 255; \
        const bf16* _kp = (_k == 2) ? ksb + (size_t)_j * 4096 : (_k == 4) ? kwb + (size_t)_j * 4096 : kcb + (size_t)_j * 4096; \
        pfk = *(const u32x4*)(_kp + soff); \
        if (_k == 2 || _k == 4 || _k == 1) { const bf16* _vp = (_k == 2) ? vsb + (size_t)_j * 4096 : (_k == 4) ? vwb + (size_t)_j * 4096 : vcb + (size_t)_j * 4096; pfv = *(const u32x4*)(_vp + soff); } } while (0)
#define ATT_COMMIT(code, par) do { const int _k = (code) >> 8; LAS unsigned char* _b = lds + (par) * BUFSZ; \
        *(LAS u32x4*)(_b + OFF_K + skey * KROW + spart * 16) = pfk; \
        if (_k == 2 || _k == 4 || _k == 1) { LAS unsigned char* _d = _b + OFF_V + skey * VROW + spart * 16; \
            u32x2 _lo, _hi; _lo.x = pfv.x; _lo.y = pfv.y; _hi.x = pfv.z; _hi.y = pfv.w; *(LAS u32x2*)_d = _lo; *(LAS u32x2*)(_d + 8) = _hi; } } while (0)
#define ATT_REAL(code) ((code) >= 0 && ((code) >> 8) != 6)

    int idx = 0, n = TN[0], par = 0, prevk = -1;
    { const int c0 = TL[0]; ATT_ISSUE(c0); ATT_COMMIT(c0, 0); const int c1 = TL[1]; ATT_ISSUE(c1); }
    __syncthreads();
    for (;;) {
        const int cur = TL[idx];
        const int kind = cur >> 8, j = cur & 255;
        int l32 = l32_, hi = hi_; asm volatile("" : "+v"(l32), "+v"(hi));
        const LAS unsigned char* qW = qW_;
        const LAS unsigned char* Kg = lds + par * BUFSZ + OFF_K; const LAS unsigned char* Vg = lds + par * BUFSZ + OFF_V;
        if (kind != prevk) {
            if (prevk == 0) {
                const float lt = l + __shfl_xor(l, 32); ilc = lt > 0.f ? 1.0f / lt : 0.f; mc = (m == NEG_INF) ? 0.f : m;
                for (int k = lane; k < 8 * 65; k += 64) impw[k] = 0.f;
            }
            if (kind == 4) {
                {
                const int n_old = n;
                unsigned lo = 0xffffffffu, hw = 0xffffffffu;
                if (qb >= 16) {
                    const int part = lane >> 3;
                    float mine[8]; int rank[8];
#pragma unroll
                    for (int k = 0; k < 8; ++k) { mine[k] = impw[qi * 65 + part * 8 + k]; rank[k] = 0; }
#pragma unroll 4
                    for (int i = 1; i <= qb - 2; ++i) {
                        const float v = impw[qi * 65 + i];
#pragma unroll
                        for (int k = 0; k < 8; ++k) { const int js = part * 8 + k; rank[k] += ((v > mine[k]) || (v == mine[k] && i < js)) ? 1 : 0; }
                    }
                    unsigned bits = 0;
#pragma unroll
                    for (int k = 0; k < 8; ++k) { const int js = part * 8 + k;
                        const bool sel = (js == 0) || (js == qb - 1) || (js == qb) || (js >= 1 && js <= qb - 2 && rank[k] < 13);
                        bits |= sel ? (1u << k) : 0u; }
                    lo = (part < 4) ? (bits << (8 * part)) : 0u;
                    hw = (part >= 4) ? (bits << (8 * (part - 4))) : 0u;
#pragma unroll
                    for (int of = 8; of < 64; of <<= 1) { lo |= __shfl_xor(lo, of); hw |= __shfl_xor(hw, of); }
                }
                sel_lo = lo; sel_hi = hw;
                unsigned ulo = lo, uhi = hw;
#pragma unroll
                for (int of = 1; of < 8; of <<= 1) { ulo |= __shfl_xor(ulo, of); uhi |= __shfl_xor(uhi, of); }
                un_lo = __builtin_amdgcn_readfirstlane(ulo); un_hi = __builtin_amdgcn_readfirstlane(uhi);
                if (lane == 0) { UM[w * 2] = un_lo; UM[w * 2 + 1] = un_hi; }
                __syncthreads();
                if (tid == 0) {
                    unsigned a = 0, c = 0; for (int k = 0; k < 8; ++k) { a |= UM[2 * k]; c |= UM[2 * k + 1]; }
                    int nn = TN[0];
                    for (int js = qb; js >= 0; --js) { const bool on = js < 32 ? ((a >> js) & 1u) : ((c >> (js - 32)) & 1u); if (on) TL[nn++] = (2 << 8) | js; }
                    TN[0] = nn;
                }
                __syncthreads();
                n = TN[0];
                if (idx + 1 >= n_old && idx + 1 < n) { const int c1 = TL[idx + 1]; ATT_ISSUE(c1); }
                }
                qx = make_qx(slope2, hi_);
                const float gc = gates[(size_t)row * 24 + head * 3];
#pragma unroll
                for (int db = 0; db < 2; ++db)
#pragma unroll
                    for (int i4 = 0; i4 < 2; ++i4) {
                        u32x4 wv;
                        wv.x = pk2_hw(o[db][8 * i4 + 0] * gc, o[db][8 * i4 + 1] * gc); wv.y = pk2_hw(o[db][8 * i4 + 2] * gc, o[db][8 * i4 + 3] * gc);
                        wv.z = pk2_hw(o[db][8 * i4 + 4] * gc, o[db][8 * i4 + 5] * gc); wv.w = pk2_hw(o[db][8 * i4 + 6] * gc, o[db][8 * i4 + 7] * gc);
                        *(LAS u32x4*)(stg + (db * 2 + i4) * 1024) = wv;
                    }
#pragma unroll
                for (int db = 0; db < 2; ++db)
#pragma unroll
                    for (int i = 0; i < 16; ++i) o[db][i] = 0.f;
            }
            if (prevk == 4) {
                const float lt = l + __shfl_xor(l, 32); const float sc = lt > 0.f ? gates[(size_t)row * 24 + head * 3 + 2] / lt : 0.f;
#pragma unroll
                for (int db = 0; db < 2; ++db)
#pragma unroll
                    for (int i4 = 0; i4 < 2; ++i4) {
                        const u32x4 pv_ = *(const LAS u32x4*)(stg + (db * 2 + i4) * 1024);
                        u32x4 wv;
                        wv.x = pk2_hw(o[db][8 * i4 + 0] * sc + bflo(pv_.x), o[db][8 * i4 + 1] * sc + bfhi(pv_.x)); wv.y = pk2_hw(o[db][8 * i4 + 2] * sc + bflo(pv_.y), o[db][8 * i4 + 3] * sc + bfhi(pv_.y));
                        wv.z = pk2_hw(o[db][8 * i4 + 4] * sc + bflo(pv_.z), o[db][8 * i4 + 5] * sc + bfhi(pv_.z)); wv.w = pk2_hw(o[db][8 * i4 + 6] * sc + bflo(pv_.w), o[db][8 * i4 + 7] * sc + bfhi(pv_.w));
                        *(LAS u32x4*)(stg + (db * 2 + i4) * 1024) = wv;
                    }
#pragma unroll
                for (int db = 0; db < 2; ++db)
#pragma unroll
                    for (int i = 0; i < 16; ++i) o[db][i] = 0.f;
            }
            m = NEG_INF; l = 0.f;
            prevk = kind;
        }
        const int nxt = (idx + 1 < n) ? TL[idx + 1] : -1;
        if (nxt >= 0) { ATT_COMMIT(nxt, par ^ 1); const int nn = (idx + 2 < n) ? TL[idx + 2] : -1; if (nn >= 0) ATT_ISSUE(nn); }
        if (kind == 0 || kind == 1) {
            f32x16 s[2];
            scores<16, true, false>(s, qx, qW, Kg, l32, hi, t - 31 - 1024 * j - 64 * hi, 0);
            const float base = -slope2 * ((float)(t - 1024 * j - 64 * hi) - 15.5f);
            if (kind == 0) stats_update(s, m, l, base);
            else {
                exp_sub_scale(s, mc - base, ilc);
                { bf16x8 pk[4]; pack_p(pk, s); SBAR_(); pv(o, pk, Vg, l32, hi); SBAR_(); }
#pragma unroll
                for (int kb = 0; kb < 2; ++kb)
#pragma unroll
                    for (int i = 0; i < 16; ++i) { float v = s[kb][i]; v += __shfl_xor(v, 8); v += __shfl_xor(v, 16); s[kb][i] = v; }
                if (l32_ < 8) {
#pragma unroll
                    for (int kb = 0; kb < 2; ++kb)
#pragma unroll
                        for (int a = 0; a < 4; ++a) {
                            const int js = 16 * j + 8 * kb + 2 * a + hi;
                            const float p3 = s[kb][4 * a + 3], mainv = 2.f * (s[kb][4 * a] + s[kb][4 * a + 1] + s[kb][4 * a + 2]) + p3;
                            impw[qi * 65 + js] += mainv;
                            impw[qi * 65 + js + 1] += p3;
                        }
                }
            }
        } else if (kind == 2) {
            const bool need = (j < 32) ? ((un_lo >> j) & 1u) : ((un_hi >> (j - 32)) & 1u);
            if (need) {
                const bool selbit = (j < 32) ? ((sel_lo >> j) & 1u) : ((sel_hi >> (j - 32)) & 1u);
                f32x16 s[2];
                if (j == qb) scores<1, true, false>(s, qx, qW, Kg, l32, hi, t - 64 * j - 4 * hi, 0);
                else scores<1, false, false>(s, qx, qW, Kg, l32, hi, 0, 0);
                online(s, o, m, l, selbit ? -slope2 * (float)(t - 64 * j - 4 * hi) : NEG_INF);
                bf16x8 pk[4]; pack_p(pk, s); SBAR_(); pv(o, pk, Vg, l32, hi);
            }
        } else if (kind == 4) {
            f32x16 s[2];
            if (j == qb) scores<1, true, false>(s, qx, qW, Kg, l32, hi, t - 64 * j - 4 * hi, 0);
            else if (j == qb - 8) scores<1, false, true>(s, qx, qW, Kg, l32, hi, 0, t - 512 - 64 * j - 4 * hi);
            else scores<1, false, false>(s, qx, qW, Kg, l32, hi, 0, 0);
            online(s, o, m, l, -slope2 * (float)(t - 64 * j - 4 * hi));
            bf16x8 pk[4]; pack_p(pk, s); SBAR_(); pv(o, pk, Vg, l32, hi);
        }
        __syncthreads();
        ++idx; par ^= 1;
        if (nxt < 0) break;
    }
    {
        const float lt = l + __shfl_xor(l, 32); const float sc = lt > 0.f ? gates[(size_t)row * 24 + head * 3 + 1] / lt : 0.f;
#pragma unroll
        for (int db = 0; db < 2; ++db)
#pragma unroll
            for (int i4 = 0; i4 < 2; ++i4) {
                const u32x4 wv = *(const LAS u32x4*)(stg + (db * 2 + i4) * 1024);
                o[db][8 * i4 + 0] = o[db][8 * i4 + 0] * sc + bflo(wv.x); o[db][8 * i4 + 1] = o[db][8 * i4 + 1] * sc + bfhi(wv.x);
                o[db][8 * i4 + 2] = o[db][8 * i4 + 2] * sc + bflo(wv.y); o[db][8 * i4 + 3] = o[db][8 * i4 + 3] * sc + bfhi(wv.y);
                o[db][8 * i4 + 4] = o[db][8 * i4 + 4] * sc + bflo(wv.z); o[db][8 * i4 + 5] = o[db][8 * i4 + 5] * sc + bfhi(wv.z);
                o[db][8 * i4 + 6] = o[db][8 * i4 + 6] * sc + bflo(wv.w); o[db][8 * i4 + 7] = o[db][8 * i4 + 7] * sc + bfhi(wv.w);
            }
    }
    float ss = 0.f;
#pragma unroll
    for (int db = 0; db < 2; ++db)
#pragma unroll
        for (int i = 0; i < 16; ++i) ss += o[db][i] * o[db][i];
    ss += __shfl_xor(ss, 8); ss += __shfl_xor(ss, 16); ss += __shfl_xor(ss, 32);
    if (lane < 8) SS[g * 64 + 8 * w + lane] = ss;
    bf16* op = mix + (size_t)row * DM + head * 64 + 4 * hi_;
#pragma unroll
    for (int db = 0; db < 2; ++db)
#pragma unroll
        for (int a = 0; a < 4; ++a) {
            u32x2 wv; wv.x = pk2(o[db][4 * a], o[db][4 * a + 1]); wv.y = pk2(o[db][4 * a + 2], o[db][4 * a + 3]);
            *(u32x2*)(op + db * 32 + 8 * a) = wv;
        }
    __syncthreads();
#undef ATT_ISSUE
#undef ATT_COMMIT
#undef ATT_REAL
}
__device__ __forceinline__ void attn_item(LAS unsigned char* lds, int b, int qb, const float* qng, const bf16* zq, const bf16* kvb, const bf16* kc, const bf16* vc, const float* gates, bf16* mix) {
#pragma nounroll
    for (int g = 0; g < 2; ++g) attn_pass(lds, b, qb, g, qng, zq, kvb, kc, vc, gates, mix);
    int tid_ = threadIdx.x; asm volatile("" : "+v"(tid_));
    const int tid = tid_, lane = tid & 63, w = __builtin_amdgcn_readfirstlane(tid >> 6), l32 = lane & 31, hi = lane >> 5, qi = lane & 7, hh = l32 >> 3;
    LAS float* SS = (LAS float*)(lds + OFF_RS);
    const int tq = 8 * w + qi, row = b * 4096 + qb * 64 + tq;
    const float rinv = __builtin_amdgcn_rsqf((SS[tq] + SS[64 + tq]) * (1.0f / 512.0f) + EPS);
#pragma nounroll
    for (int g = 0; g < 2; ++g) {
        bf16* op = mix + (size_t)row * DM + (g * 4 + hh) * 64 + 4 * hi;
#pragma unroll
        for (int db = 0; db < 2; ++db)
#pragma unroll
            for (int a = 0; a < 4; ++a) {
                u32x2* p = (u32x2*)(op + db * 32 + 8 * a);
                const u32x2 v = *p; u32x2 wv; wv.x = pk2(bflo(v.x) * rinv, bfhi(v.x) * rinv); wv.y = pk2(bflo(v.y) * rinv, bfhi(v.y) * rinv);
                *p = wv;
            }
    }
    __syncthreads();
}
}
#ifndef PHASES
#define PHASES 0x1ff
#endif

__device__ __forceinline__ void gmlp_item(LAS unsigned char* lds, int item, const bf16* zu, const bf16* zv, bf16* mix, const float* ln_g, const float* ln_b, const bf16* wsb, const float* gbs) {
    int tid_ = threadIdx.x; asm volatile("" : "+v"(tid_));
    const int tid = tid_, lane = tid & 63, w = __builtin_amdgcn_readfirstlane(tid >> 6);
    const int r0 = item * 128;
    constexpr int WROW = 272;
    LAS unsigned char* VT = lds;
    u32x2 uall[8][4];
    {
        const bf16* up = zu + (size_t)(r0 + 16 * w + (lane & 15)) * 512 + (lane >> 4) * 4;
#pragma unroll
        for (int g = 0; g < 8; ++g)
#pragma unroll
            for (int nb = 0; nb < 4; ++nb) uall[g][nb] = *(const u32x2*)(up + g * 64 + nb * 16);
    }
    {
        f32x4 g0 = *(const f32x4*)(ln_g + lane * 8), g1 = *(const f32x4*)(ln_g + lane * 8 + 4), b0 = *(const f32x4*)(ln_b + lane * 8), b1 = *(const f32x4*)(ln_b + lane * 8 + 4);
#pragma unroll 4
        for (int k = 0; k < 16; ++k) {
            const int tl = w * 16 + k;
            const u32x4 v = *(const u32x4*)(zv + (size_t)(r0 + tl) * 512 + lane * 8);
            float f[8] = {bflo(v.x), bfhi(v.x), bflo(v.y), bfhi(v.y), bflo(v.z), bfhi(v.z), bflo(v.w), bfhi(v.w)};
            float s = ((f[0] + f[1]) + (f[2] + f[3])) + ((f[4] + f[5]) + (f[6] + f[7]));
            float s2 = ((f[0] * f[0] + f[1] * f[1]) + (f[2] * f[2] + f[3] * f[3])) + ((f[4] * f[4] + f[5] * f[5]) + (f[6] * f[6] + f[7] * f[7]));
            s = wave_sum(s); s2 = wave_sum(s2);
            const float mean = s * (1.0f / 512.0f), var = fmaxf(s2 * (1.0f / 512.0f) - mean * mean, 0.f), rs = __builtin_amdgcn_rsqf(var + EPS);
#pragma unroll
            for (int e = 0; e < 8; ++e) {
                const float gg = e < 4 ? g0[e] : g1[e - 4], bb = e < 4 ? b0[e] : b1[e - 4];
                *(LAS unsigned short*)(VT + (lane * 8 + e) * WROW + (((tl >> 3) ^ (lane & 7)) << 4) + (tl & 7) * 2) = (unsigned short)f2bf((f[e] - mean) * rs * gg + bb);
            }
        }
    }
    __syncthreads();
    const int tl = 16 * w + (lane & 15), fq = lane >> 4;
    const int nks = (16 * w + 15) / 32 + 1;
    float ssq = 0.f;
    bf16x8 nb_fr[4]; float nbias;
#define GMLP_FETCH(g_) do { const bf16* wrow_ = wsb + ((size_t)((g_) * 128 + tl)) * 128 + fq * 8; \
        _Pragma("unroll") for (int ks = 0; ks < 4; ++ks) if (ks < nks) nb_fr[ks] = *(const bf16x8*)(wrow_ + ks * 32); \
        nbias = gbs[(g_) * 128 + tl]; } while (0)
    GMLP_FETCH(0);
#pragma unroll
    for (int g = 0; g < 8; ++g) {
        bf16x8 bfr[4]; u32x2 uu[4];
#pragma unroll
        for (int ks = 0; ks < 4; ++ks) bfr[ks] = nb_fr[ks];
#pragma unroll
        for (int nb = 0; nb < 4; ++nb) uu[nb] = uall[g][nb];
        const float bias = nbias;
        if (g < 7) GMLP_FETCH(g + 1);
        pg8::f32x4 c[4];
#pragma unroll
        for (int nb = 0; nb < 4; ++nb) c[nb] = (pg8::f32x4){0.f, 0.f, 0.f, 0.f};
#pragma unroll
        for (int ks = 0; ks < 4; ++ks) if (ks < nks) {
#pragma unroll
            for (int nb = 0; nb < 4; ++nb) {
                const bf16x8 afr = *(const LAS bf16x8*)(VT + (g * 64 + nb * 16 + (lane & 15)) * WROW + (((ks * 4 + fq) ^ ((nb * 2 + ((lane & 15) >> 3)) & 7)) << 4));
                c[nb] = __builtin_amdgcn_mfma_f32_16x16x32_bf16(afr, bfr[ks], c[nb], 0, 0, 0);
            }
        }
#pragma unroll
        for (int nb = 0; nb < 4; ++nb) {
            const int d0 = nb * 16 + fq * 4;
            const float v0 = bflo(uu[nb].x) * (c[nb][0] + bias), v1 = bfhi(uu[nb].x) * (c[nb][1] + bias), v2 = bflo(uu[nb].y) * (c[nb][2] + bias), v3 = bfhi(uu[nb].y) * (c[nb][3] + bias);
            ssq += (v0 * v0 + v1 * v1) + (v2 * v2 + v3 * v3);
            u32x2 o; o.x = pk2(v0, v1); o.y = pk2(v2, v3);
            *(u32x2*)(mix + (size_t)(r0 + tl) * DM + 512 + g * 64 + d0) = o;
        }
    }
#undef GMLP_FETCH
    ssq += __shfl_xor(ssq, 16); ssq += __shfl_xor(ssq, 32);
    const float rinv = __builtin_amdgcn_rsqf(ssq * (1.0f / 512.0f) + EPS);
    for (int g = 0; g < 8; ++g)
#pragma unroll
        for (int nb = 0; nb < 4; ++nb) {
            u32x2* p = (u32x2*)(mix + (size_t)(r0 + tl) * DM + 512 + g * 64 + nb * 16 + fq * 4);
            const u32x2 v = *p; u32x2 o; o.x = pk2(bflo(v.x) * rinv, bfhi(v.x) * rinv); o.y = pk2(bflo(v.y) * rinv, bfhi(v.y) * rinv);
            *p = o;
        }
    __syncthreads();
}

#define PHASE_PTRS() \
    unsigned char* ws = args.ws; asm volatile("" : "+s"(ws)); \
    int tidp_ = threadIdx.x; asm volatile("" : "+v"(tidp_)); \
    const int tid = tidp_, lane = tid & 63, w = __builtin_amdgcn_readfirstlane(tid >> 6), gw = bx * 8 + w, NGW = G * 8; (void)lane; (void)gw; (void)NGW; \
    const float* x = args.in[I_X]; (void)x; \
    float* b1p = (float*)(ws + WS_B1P); (void)b1p; \
    bf16* WinT = (bf16*)(ws + WS_WIN); bf16* WoT = (bf16*)(ws + WS_WO); bf16* W1T = (bf16*)(ws + WS_W1); bf16* W2T = (bf16*)(ws + WS_W2); (void)WinT; (void)WoT; (void)W1T; (void)W2T; \
    bf16* WgT = (bf16*)(ws + WS_WG); bf16* WpT = (bf16*)(ws + WS_WP); bf16* Wc1K = (bf16*)(ws + WS_WC1K); bf16* Wc1V = (bf16*)(ws + WS_WC1V); (void)WgT; (void)WpT; (void)Wc1K; (void)Wc1V; \
    float* rss1 = (float*)(ws + WS_RSS1); float* rss2 = (float*)(ws + WS_RSS2); (void)rss1; (void)rss2; \
    bf16* xb = (bf16*)(ws + WS_XB); bf16* pb = (bf16*)(ws + WS_PB); bf16* tp = (bf16*)(ws + WS_TP); bf16* h1 = (bf16*)(ws + WS_H1); (void)xb; (void)pb; (void)tp; (void)h1; \
    bf16* zq = (bf16*)(ws + WS_ZQ); bf16* zu = (bf16*)(ws + WS_ZU); bf16* zv = (bf16*)(ws + WS_ZV); bf16* mix = (bf16*)(ws + WS_MIX); (void)zq; (void)zu; (void)zv; (void)mix; \
    bf16* kvb = (bf16*)(ws + WS_KV); float* gates = (float*)(ws + WS_GATES); bf16* hdnK = (bf16*)(ws + WS_HDNK); bf16* hdnV = (bf16*)(ws + WS_HDNV); (void)kvb; (void)gates; (void)hdnK; (void)hdnV; \
    bf16* kc = (bf16*)(ws + WS_KC); bf16* vc = (bf16*)(ws + WS_VC); (void)kc; (void)vc; \
    bf16* wsb = (bf16*)(ws + WS_WSB); (void)wsb; float* hpart = (float*)(ws + WS_HDNK); (void)hpart;

__global__ void __launch_bounds__(512) fwd_megakernel(Args args) {
    extern __shared__ __attribute__((aligned(16))) unsigned char lds_raw[];
    LAS unsigned char* lds = (LAS unsigned char*)lds_raw;
    cg::grid_group grid = cg::this_grid();
    volatile LAS unsigned* MISC = (volatile LAS unsigned*)(lds + LDS_BYTES - 64);
    if (threadIdx.x < 16) MISC[threadIdx.x] = 0u;
    __syncthreads();
    if (blockIdx.x == 0) { unsigned* bw = (unsigned*)(args.ws + WS_BAR); for (int u = threadIdx.x; u < 4096; u += 512) __hip_atomic_store(bw + u, 0u, __ATOMIC_RELAXED, __HIP_MEMORY_SCOPE_AGENT); __threadfence(); }
    XcdBarrier xbar;
    const int G = gridDim.x, bx = blockIdx.x;

    #if (PHASES >> 0) & 1
    {
    PHASE_PTRS()
    if (bx < 32) {
        const int which = (bx >> 2) & 1, cgp = bx & 3, kq = bx >> 3, col = cgp * 64 + lane;
        const float* pos = args.in[which ? I_POSV : I_POSK]; const float* w1 = args.in[which ? I_CVW1 : I_CKW1]; const float* b1 = args.in[which ? I_CVB1 : I_CKB1];
        float acc8[16];
#pragma unroll
        for (int u = 0; u < 16; ++u) acc8[u] = 0.f;
        for (int k = kq * 512 + w * 64; k < kq * 512 + w * 64 + 64; k += 16) {
#pragma unroll
            for (int u = 0; u < 16; ++u) acc8[u] += pos[k + u] * w1[(size_t)(k + u) * 256 + col];
        }
        float acc = 0.f;
#pragma unroll
        for (int u = 0; u < 16; ++u) acc += acc8[u];
        LAS float* red = (LAS float*)lds;
        red[w * 64 + lane] = acc;
        __syncthreads();
        if (w == 0) { float s = kq == 0 ? b1[col] : 0.f; for (int k = 0; k < 8; ++k) s += red[k * 64 + lane]; b1p[kq * 512 + which * 256 + col] = s; }
        __syncthreads();
    }
    {
        LAS float* scr = (LAS float*)(lds + w * 16384);
        constexpr int N_IN_A = 16 * 40, N_IN_B = 16 * 32, N_IN_C = 16, N_O = 16 * 32, N_1 = 16 * 128, N_2 = 64 * 32, N_G = 16 * 32, N_P = 4 * 32, N_C = 32 * 8;
        constexpr int NITEMS = N_IN_A + N_IN_B + N_IN_C + N_O + N_1 + N_2 + N_G + N_P + 2 * N_C;
        for (int it = gw; it < NITEMS; it += NGW) {
            int r = it;
            if (r < N_IN_A) { tr_item(args.in[I_WIN], 2328, (r / 40) * 64, (r % 40) * 32, WinT, 1024, (r % 40) * 32, args.in[I_GMIX], scr, lane); continue; } r -= N_IN_A;
            if (r < N_IN_B) { tr_item(args.in[I_WIN], 2328, (r / 32) * 64, 1304 + (r % 32) * 32, WinT, 1024, 1280 + (r % 32) * 32, args.in[I_GMIX], scr, lane); continue; } r -= N_IN_B;
            if (r < N_IN_C) { tr_item(args.in[I_WIN], 2328, r * 64, 1280, WinT, 1024, 2304, args.in[I_GMIX], scr, lane); continue; } r -= N_IN_C;
            if (r < N_O) { const int k0 = (r / 32) * 64; tr_item(args.in[I_WOUT], 1024, k0, (r % 32) * 32, WoT, 1024, (r % 32) * 32, k0 < 512 ? args.in[I_OGN] : args.in[I_OGG] - 512, scr, lane); continue; } r -= N_O;
            if (r < N_1) { tr_item(args.in[I_WFF1], 4096, (r / 128) * 64, (r % 128) * 32, W1T, 1024, (r % 128) * 32, args.in[I_GFF], scr, lane); continue; } r -= N_1;
            if (r < N_2) { tr_item(args.in[I_WFF2], 1024, (r / 32) * 64, (r % 32) * 32, W2T, 4096, (r % 32) * 32, nullptr, scr, lane); continue; } r -= N_2;
            if (r < N_G) { tr_item(args.in[I_WPG], 1024, (r / 32) * 64, (r % 32) * 32, WgT, 1024, (r % 32) * 32, args.in[I_GPLE], scr, lane); continue; } r -= N_G;
            if (r < N_P) { tr_item(args.in[I_WPLE], 1024, (r / 32) * 64, (r % 32) * 32, WpT, 256, (r % 32) * 32, nullptr, scr, lane); continue; } r -= N_P;
            if (r < N_C) { tr_item(args.in[I_CKW1], 256, (r / 8) * 64, (r % 8) * 32, Wc1K, 2048, (r % 8) * 32, nullptr, scr, lane); continue; } r -= N_C;
            tr_item(args.in[I_CVW1], 256, (r / 8) * 64, (r % 8) * 32, Wc1V, 2048, (r % 8) * 32, nullptr, scr, lane);
        }
        for (int e = bx * 512 + tid; e < 8 * 128 * 128; e += G * 512) {
            const int tt = (e >> 7) & 127, sx = e & 127;
            wsb[e] = (bf16)f2bf(sx <= tt ? args.in[I_GWS][e] : 0.f);
        }
        for (int m0 = gw * 2; m0 < MROWS; m0 += NGW * 2) {
            f32x4 v[2][4]; f32x4 pv4[2]; float s[2];
#pragma unroll
            for (int r = 0; r < 2; ++r) {
                const f32x4* xr = (const f32x4*)(x + (size_t)(m0 + r) * DM) + lane;
#pragma unroll
                for (int j = 0; j < 4; ++j) v[r][j] = xr[64 * j];
                pv4[r] = *((const f32x4*)(args.in[I_P] + (size_t)(m0 + r) * DPLE) + lane);
            }
#pragma unroll
            for (int r = 0; r < 2; ++r) { s[r] = 0.f;
#pragma unroll
                for (int j = 0; j < 4; ++j) s[r] += (v[r][j][0] * v[r][j][0] + v[r][j][1] * v[r][j][1]) + (v[r][j][2] * v[r][j][2] + v[r][j][3] * v[r][j][3]); }
#pragma unroll
            for (int o = 1; o < 64; o <<= 1) { s[0] += __shfl_xor(s[0], o); s[1] += __shfl_xor(s[1], o); }
#pragma unroll
            for (int r = 0; r < 2; ++r) {
                const float rinv = __builtin_amdgcn_rsqf(s[r] * (1.0f / DM) + EPS);
                u32x2* o8 = (u32x2*)(xb + (size_t)(m0 + r) * DM) + lane;
#pragma unroll
                for (int j = 0; j < 4; ++j) { u32x2 o; o.x = pk2(v[r][j][0] * rinv, v[r][j][1] * rinv); o.y = pk2(v[r][j][2] * rinv, v[r][j][3] * rinv); o8[64 * j] = o; }
                u32x2 po; po.x = pk2(pv4[r][0], pv4[r][1]); po.y = pk2(pv4[r][2], pv4[r][3]);
                *((u32x2*)(pb + (size_t)(m0 + r) * DPLE) + lane) = po;
            }
        }
    }
        }
    grid.sync();
    xbar = xcd_barrier_post((unsigned*)(args.ws + WS_BAR), MISC + 8);

    #endif
#if (PHASES >> 1) & 1
    {
    PHASE_PTRS()
    {
        pg8::Gemm g{xb, WinT, MROWS, NINP, DM, DM, DM}; pg8::StaticOrder S; S.init(MROWS, NINP, G, bx);
        EpiRow<FIn> E{FIn{zq, kvb, zu, zv, gates}};
        pg8::gemm_phase<EpiRow<FIn>, pg8::StaticOrder, true, true>(lds, g, S, E);
    }
        }
    xcd_barrier(xbar);

    #endif
#if (PHASES >> 2) & 1
    {
    PHASE_PTRS()
    {
        const size_t nth = (size_t)G * 512, gt = (size_t)bx * 512 + tid;
        constexpr size_t NQR = 0, NKR = (size_t)MROWS * 2;
        for (size_t c = gt; c < (NQR + 2 * NKR) * 8; c += nth) {
            const size_t r = c >> 3; const int part = (int)(c & 7);
            bf16* p; const float* gn; float sc;
            if (r < NQR) { p = zq + r * 64; gn = args.in[I_QG]; sc = QSCALE; }
            else if (r < NQR + NKR) { p = kvb + 2 * KV_STRIDE + (r - NQR) * 64; gn = args.in[I_KSG]; sc = 1.f; }
            else { p = kvb + 4 * KV_STRIDE + (r - NQR - NKR) * 64; gn = args.in[I_KWG]; sc = 1.f; }
            const u32x4 v = *(const u32x4*)(p + part * 8);
            float f[8] = {bflo(v.x), bfhi(v.x), bflo(v.y), bfhi(v.y), bflo(v.z), bfhi(v.z), bflo(v.w), bfhi(v.w)};
            float s = 0.f;
#pragma unroll
            for (int e = 0; e < 8; ++e) s += f[e] * f[e];
            s += __shfl_xor(s, 1); s += __shfl_xor(s, 2); s += __shfl_xor(s, 4);
            const float rinv = __builtin_amdgcn_rsqf(s * (1.0f / 64.0f) + EPS) * sc;
#pragma unroll
            for (int e = 0; e < 8; ++e) f[e] = f[e] * rinv * gn[part * 8 + e];
            u32x4 o; o.x = pk2(f[0], f[1]); o.y = pk2(f[2], f[3]); o.z = pk2(f[4], f[5]); o.w = pk2(f[6], f[7]);
            *(u32x4*)(p + part * 8) = o;
        }
    }
    {
        const int u = bx < 128 ? bx : -1, which = (u >> 6) & 1, pm = (u >> 2) & 15, sl = u & 3;
        pg8::Gemm g{kvb + (which ? KV_STRIDE : 0) + sl * 512, (which ? Wc1V : Wc1K) + sl * 512, 4096, 256, 512, 1024, 2048}; OneUnit S{u >= 0 ? pm : -1};
        EpiRow<FPart> E{FPart{hpart + ((size_t)which * 4 + sl) * 4096 * 256}};
        pg8::gemm_phase<EpiRow<FPart>, OneUnit, true, true>(lds, g, S, E);
    }
    {
        pg8::Gemm g{pb, WpT, MROWS, DM, DPLE, DPLE, DPLE}; TpDeal S{bx, G};
        EpiRow<FPlain> E{FPlain{tp, DM}};
        pg8::gemm_phase<EpiRow<FPlain>, TpDeal, true, true>(lds, g, S, E);
    }
    {
        for (int it = bx; it < 256; it += G) gmlp_item(lds, it, zu, zv, mix, args.in[I_LNG], args.in[I_LNB], wsb, args.in[I_GBS]);
    }
        }
    xcd_barrier(xbar);

    #endif
#if (PHASES >> 3) & 1
    {
    PHASE_PTRS()
    {
    LAS float* hw = (LAS float*)(lds + w * 4096);
    for (int pr = gw; pr < 2 * 1024; pr += NGW) {
        const int p_ = __builtin_amdgcn_readfirstlane(pr), which = p_ >> 10, ri0 = p_ & 1023;
        const float* w2 = args.in[which ? I_CVW2 : I_CKW2];
        f32x4 hb = *(const f32x4*)(b1p + which * 256 + lane * 4);
#pragma unroll
        for (int kq = 1; kq < 4; ++kq) hb += *(const f32x4*)(b1p + kq * 512 + which * 256 + lane * 4);
        f32x4 hr[4];
#pragma unroll
        for (int q = 0; q < 4; ++q) { hr[q] = hb; const float* hp = hpart + ((size_t)which * 4 * 4096 + ri0 + q * 1024) * 256 + lane * 4;
#pragma unroll
            for (int sl = 0; sl < 4; ++sl) hr[q] += *(const f32x4*)(hp + (size_t)sl * 4096 * 256); }
#pragma unroll
        for (int q = 0; q < 4; ++q) {
#pragma unroll
            for (int e = 0; e < 4; ++e) hr[q][e] = gelu_tanh(hr[q][e]);
            *(LAS f32x4*)(hw + q * 256 + lane * 4) = hr[q]; }
        const float bias2 = args.in[which ? I_CVB2 : I_CKB2][lane];
        float accr[4] = {bias2, bias2, bias2, bias2};
#pragma unroll 4
        for (int k2 = 0; k2 < 256; k2 += 4) {
            const float w0 = w2[k2 * 64 + lane], w1 = w2[(k2 + 1) * 64 + lane], w2v = w2[(k2 + 2) * 64 + lane], w3 = w2[(k2 + 3) * 64 + lane];
#pragma unroll
            for (int q = 0; q < 4; ++q) { const f32x4 hq = *(const LAS f32x4*)(hw + q * 256 + k2); accr[q] += hq[0] * w0 + hq[1] * w1 + hq[2] * w2v + hq[3] * w3; } }
#pragma unroll
        for (int q = 0; q < 4; ++q) {
            const int ri = ri0 + q * 1024; float acc = accr[q];
            bf16* op = which ? vc + (size_t)(ri >> 8) * 16384 + (size_t)((ri & 255) >> 6) * 4096 + (size_t)lane * 64 + (ri & 63) : kc + (size_t)ri * 64 + lane;
            if ((ri & 255) == 255) { *op = 0; continue; }
            if (!which) { const float ssum = wave_sum(acc * acc); acc *= __builtin_amdgcn_rsqf(ssum * (1.0f / 64.0f) + EPS) * args.in[I_KCG][lane]; }
            *op = (bf16)f2bf(acc);
        }
    }
    }
        }
    xcd_barrier(xbar);

    #endif
#if (PHASES >> 4) & 1
    {
    PHASE_PTRS()
    for (int pi = bx; pi < 256; pi += G) {
        const int b = pi >> 5, qa = pi & 31;
#pragma nounroll
        for (int hh = 0; hh < 2; ++hh) att::attn_item(lds, b, hh ? qa : 63 - qa, args.in[I_QG], zq, kvb, kc, vc, gates, mix);
    }
        }
    xcd_barrier(xbar);

    #endif
#if (PHASES >> 5) & 1
    {
    PHASE_PTRS()
    {
        pg8::Gemm g{mix, WoT, MROWS, DM, DM, DM, DM}; pg8::StaticOrder S; S.init(MROWS, DM, G, bx);
        EpiRowP<FResA> E{FResA{x, xb, rss1}};
        pg8::gemm_phase<EpiRowP<FResA>, pg8::StaticOrder, true, true>(lds, g, S, E);
    }
        }
    xcd_barrier(xbar);
    #endif
#if (PHASES >> 6) & 1
    {
    PHASE_PTRS()
    {
        pg8::Gemm g{xb, W1T, MROWS, FF, DM, DM, DM}; pg8::StaticOrder S; S.init(MROWS, FF, G, bx);
        EpiRowP<FFF1> E{FFF1{h1, rss1}};
        pg8::gemm_phase<EpiRowP<FFF1>, pg8::StaticOrder, true, true>(lds, g, S, E);
    }
        }
    xcd_barrier(xbar);
    #endif
#if (PHASES >> 7) & 1
    {
    PHASE_PTRS()
    {
        pg8::Gemm g{h1, W2T, MROWS, DM, FF, FF, FF}; pg8::StaticOrder S; S.init(MROWS, DM, G, bx);
        EpiRowP<FResB> E{FResB{args.out, xb, rss2}};
        pg8::gemm_phase<EpiRowP<FResB>, pg8::StaticOrder, true, true>(lds, g, S, E);
    }
        }
    xcd_barrier(xbar);
    #endif
#if (PHASES >> 8) & 1
    {
    PHASE_PTRS()
    {
        pg8::Gemm g{xb, WgT, MROWS, DM, DM, DM, DM}; pg8::StaticOrder S; S.init(MROWS, DM, G, bx);
        EpiRow<FGate> E{FGate{args.out, tp, rss2}};
        pg8::gemm_phase<EpiRow<FGate>, pg8::StaticOrder, true, true>(lds, g, S, E);
    }
    }
    #endif
}

extern "C" void kernel_launch(void* const* d_in, const int* in_sizes, int n_in, void* d_out, int out_size, void* d_ws, size_t ws_size, hipStream_t stream) {
    static int grid = 0;
    if (!grid) {
        int dev = 0, cus = 0, per_cu = 0;
        hipGetDevice(&dev);
        hipDeviceGetAttribute(&cus, hipDeviceAttributeMultiprocessorCount, dev);
        hipFuncSetAttribute((const void*)fwd_megakernel, hipFuncAttributeMaxDynamicSharedMemorySize, LDS_BYTES);
        hipOccupancyMaxActiveBlocksPerMultiprocessor(&per_cu, (const void*)fwd_megakernel, 512, LDS_BYTES);
        if (per_cu < 1) per_cu = 1;
        grid = cus * per_cu;
        if (n_in != 31 || ws_size < WS_BIG + 256 * MiB) fprintf(stderr, "kernel_launch: unexpected n_in %d / ws %zu\n", n_in, ws_size);
    }
    Args a{};
    for (int i = 0; i < 31; ++i) a.in[i] = (const float*)d_in[i];
    a.out = (float*)d_out; a.ws = (unsigned char*)d_ws;
    void* args[] = {&a};
    hipError_t e = hipLaunchCooperativeKernel((void*)fwd_megakernel, dim3(grid), dim3(512), args, LDS_BYTES, stream);
    if (e != hipSuccess) fprintf(stderr, "cooperative launch failed: %s (grid %d)\n", hipGetErrorString(e), grid);
}
```

```cpp
#include <hip/hip_runtime.h>
#include <hip/hip_cooperative_groups.h>
#include <cstdio>
#include <cstdint>
namespace cg = cooperative_groups;
namespace pg8 {
#define PG8_LAS __attribute__((address_space(3)))
typedef unsigned short bf16_t;
typedef short bf16x8 __attribute__((ext_vector_type(8)));
typedef float f32x4 __attribute__((ext_vector_type(4)));
typedef unsigned u32x4 __attribute__((ext_vector_type(4)));
constexpr int BM = 256, BK = 64, HALF = 128, HTB = HALF * BK * 2  , STAGE_BYTES = 8 * HTB, NXCD = 8, WGM = 8;

__host__ __device__ __forceinline__ int lds_byte(int r, int c) { const int st = (r >> 4) * 2 + (c >> 5), rr = r & 15, cc = c & 31, ob = rr * 64 + cc * 2; return st * 1024 + (ob ^ (((ob >> 9) & 1) << 5)); }
__host__ __device__ __forceinline__ void stage_rc(int b, int& R, int& C) { const int st = b / 1024, sb = b % 1024, swz = sb ^ (((sb >> 9) & 1) << 5); R = (st >> 1) * 16 + swz / 64; C = (st & 1) * 32 + (swz % 64) / 2; }
__host__ __device__ __forceinline__ int perm32(int rho) { const int n = rho >> 4, i = rho & 15; return 8 * (i >> 2) + 4 * n + (i & 3); }

struct Unit { int pm, pn; };
struct Gemm { const bf16_t* A; const bf16_t* Bt; int M, N, K, lda, ldb; };

struct StaticOrder {
    int nM, nN, nwg, G, c;
    __host__ __device__ void init(int M, int N, int G_, int c_) { nM = M / BM; nN = N / BM; nwg = nM * nN; G = G_; c = c_; }
    __host__ __device__ bool next(int i, Unit& u) const {
        const long L = (long)i * G + c; if (L >= nwg) return false;
        int wgid = (int)L; { const int q = nwg / NXCD, r = nwg % NXCD, xcd = wgid % NXCD, off = wgid / NXCD; wgid = (xcd < r ? xcd * (q + 1) : r * (q + 1) + (xcd - r) * q) + off; }
        const int nig = WGM * nN, gid = wgid / nig, fm = gid * WGM, gsz = (nM - fm) < WGM ? (nM - fm) : WGM;
        u.pm = fm + ((wgid % nig) % gsz); u.pn = (wgid % nig) / gsz; return true;
    }
    __device__ __forceinline__ void a_ready(const Unit&) const {}
    __device__ __forceinline__ void done(const Unit&) const {}
};

__device__ __forceinline__ unsigned cvt_pk_bf16(float lo, float hi) { unsigned r; asm volatile("v_cvt_pk_bf16_f32 %0, %1, %2" : "=v"(r) : "v"(lo), "v"(hi)); return r; }
template <class Epi, class Sched, bool ALIGN_EPI = false, bool SP2 = false>
__device__ __forceinline__ void gemm_phase(PG8_LAS unsigned char* lds, const Gemm g, const Sched& S, const Epi& E) {
    int tid_ = threadIdx.x; asm volatile("" : "+v"(tid_));
    const int tid = tid_, wid = __builtin_amdgcn_readfirstlane(tid >> 6), lane = tid & 63, wr = wid >> 2, wc = wid & 3, fr = lane & 15, fq = lane >> 4;
    const int K = g.K, nt = K / BK;
    unsigned voffA[2], voffB[2];
#pragma unroll
    for (int i = 0; i < 2; ++i) { int R, C; stage_rc(tid * 16 + i * 8192, R, C); const int Rb = Epi::PERM ? ((R & ~31) + perm32(R & 31)) : R;
        voffA[i] = (unsigned)(R * g.lda + C) * 2u; voffB[i] = (unsigned)(Rb * g.ldb + C) * 2u; }
    const size_t kstep = (size_t)(BK * 2);
    const size_t hstepA = (size_t)HALF * g.lda * 2, hstepB = (size_t)HALF * g.ldb * 2;
    const size_t tstepA = 2 * hstepA, tstepB = 2 * hstepB;
    const unsigned ldsw = (unsigned)wid * 1024u;
    const int aoff = lds_byte(wr * 64 + fr, fq * 8), boff = lds_byte(wc * 32 + fr, fq * 8);
#define PG8_SA(b, h) (((b) * 2 + (h)) * HTB)
#define PG8_SB(b, h) ((4 + (b) * 2 + (h)) * HTB)
#define PG8_STAGE(bufoff, gbase, voff) do { _Pragma("unroll") for (int _i = 0; _i < 2; ++_i) \
        __builtin_amdgcn_global_load_lds((const unsigned*)((const char*)(gbase) + (voff)[_i]), (PG8_LAS unsigned*)(lds + (bufoff) + ldsw + _i * 8192), 16, 0, 0); } while (0)
#define PG8_LDA(dst, b, h) do { _Pragma("unroll") for (int m = 0; m < 4; ++m) _Pragma("unroll") for (int k = 0; k < 2; ++k) dst[m][k] = *(const PG8_LAS bf16x8*)(lds + PG8_SA(b, h) + aoff + m * 2048 + k * 1024); } while (0)
#define PG8_LDB(dst, b, h) do { _Pragma("unroll") for (int n = 0; n < 2; ++n) _Pragma("unroll") for (int k = 0; k < 2; ++k) dst[n][k] = *(const PG8_LAS bf16x8*)(lds + PG8_SB(b, h) + boff + n * 2048 + k * 1024); } while (0)
#define PG8_MMA(ai, bj, At, Bt) do { __builtin_amdgcn_s_setprio(1); _Pragma("unroll") for (int m = 0; m < 4; ++m) _Pragma("unroll") for (int n = 0; n < 2; ++n) _Pragma("unroll") for (int k = 0; k < 2; ++k) \
        acc[ai][bj][m][n] = __builtin_amdgcn_mfma_f32_16x16x32_bf16(Bt[n][k], At[m][k], acc[ai][bj][m][n], 0, 0, 0); __builtin_amdgcn_s_setprio(0); } while (0)
#define PG8_WAIT_V(n) asm volatile("s_waitcnt vmcnt(" #n ")" ::: "memory")
#define PG8_WAIT_L(n) asm volatile("s_waitcnt lgkmcnt(" #n ")" ::: "memory")
#define PG8_BAR __builtin_amdgcn_s_barrier()
#define PG8_SCHED __builtin_amdgcn_sched_barrier(0)
    Unit cur, nxt; int ui = 0;
    if (!S.next(0, cur)) return;
    f32x4 acc[2][2][4][2];
#pragma unroll
    for (int a = 0; a < 2; ++a)
#pragma unroll
        for (int b = 0; b < 2; ++b)
#pragma unroll
            for (int m = 0; m < 4; ++m)
#pragma unroll
                for (int n = 0; n < 2; ++n) acc[a][b][m][n] = (f32x4){0.f, 0.f, 0.f, 0.f};
    bf16x8 At[4][2], B0[2][2], B1[2][2];
    const char* cA = (const char*)g.A + (size_t)cur.pm * tstepA; const char* cB = (const char*)g.Bt + (size_t)cur.pn * tstepB;
    S.a_ready(cur);
    if constexpr (SP2) {
        PG8_STAGE(PG8_SB(0, 0), cB, voffB); PG8_STAGE(PG8_SB(0, 1), cB + hstepB, voffB); PG8_STAGE(PG8_SA(0, 0), cA, voffA); PG8_STAGE(PG8_SA(0, 1), cA + hstepA, voffA);
        if (wr == 1) PG8_BAR;
        PG8_WAIT_V(2); PG8_BAR;
        PG8_STAGE(PG8_SB(1, 0), cB + kstep, voffB); PG8_STAGE(PG8_SA(1, 0), cA + kstep, voffA); PG8_STAGE(PG8_SB(1, 1), cB + hstepB + kstep, voffB);
        PG8_WAIT_V(6); PG8_BAR;
    } else {
        PG8_STAGE(PG8_SB(0, 0), cB, voffB); PG8_STAGE(PG8_SA(0, 0), cA, voffA); PG8_STAGE(PG8_SB(0, 1), cB + hstepB, voffB); PG8_STAGE(PG8_SA(0, 1), cA + hstepA, voffA);
        if (wr == 1) PG8_BAR;
        PG8_WAIT_V(4); PG8_BAR;
        PG8_STAGE(PG8_SB(1, 0), cB + kstep, voffB); PG8_STAGE(PG8_SA(1, 0), cA + kstep, voffA); PG8_STAGE(PG8_SB(1, 1), cB + hstepB + kstep, voffB);
        PG8_WAIT_V(6); PG8_BAR;
    }
    for (;;) {
        const bool has_next = S.next(ui + 1, nxt);
        const char* nA = has_next ? (const char*)g.A + (size_t)nxt.pm * tstepA : cA; const char* nB = has_next ? (const char*)g.Bt + (size_t)nxt.pn * tstepB : cB;
        for (int t = 0; t < nt; t += 2) {
            const bool last = (t == nt - 2);
            const char* a1 = cA + (size_t)(t + 1) * kstep;
            const char* a2 = last ? nA : cA + (size_t)(t + 2) * kstep; const char* b2 = last ? nB : cB + (size_t)(t + 2) * kstep;
            const char* a3 = a2 + kstep; const char* b3 = b2 + kstep;
            if (last && has_next) S.a_ready(nxt);
            if constexpr (SP2) {
            PG8_LDB(B0, 0, 0); PG8_LDB(B1, 0, 1); PG8_SCHED; PG8_LDA(At, 0, 0); PG8_STAGE(PG8_SA(1, 1), a1 + hstepA, voffA);
            PG8_WAIT_V(8); PG8_WAIT_L(0); PG8_BAR; PG8_MMA(0, 0, At, B0); PG8_MMA(0, 1, At, B1); PG8_BAR; PG8_SCHED;
            PG8_LDA(At, 0, 1); PG8_STAGE(PG8_SB(0, 0), b2, voffB); PG8_STAGE(PG8_SB(0, 1), b2 + hstepB, voffB); PG8_STAGE(PG8_SA(0, 0), a2, voffA);
            PG8_WAIT_V(8); PG8_WAIT_L(0); PG8_BAR; PG8_MMA(1, 0, At, B0); PG8_MMA(1, 1, At, B1); PG8_BAR; PG8_SCHED;
            PG8_LDB(B0, 1, 0); PG8_LDB(B1, 1, 1); PG8_SCHED; PG8_LDA(At, 1, 0); PG8_STAGE(PG8_SA(0, 1), a2 + hstepA, voffA);
            PG8_WAIT_V(8); PG8_WAIT_L(0); PG8_BAR; PG8_MMA(0, 0, At, B0); PG8_MMA(0, 1, At, B1); PG8_BAR; PG8_SCHED;
            PG8_LDA(At, 1, 1); PG8_STAGE(PG8_SB(1, 0), b3, voffB); PG8_STAGE(PG8_SB(1, 1), b3 + hstepB, voffB); PG8_STAGE(PG8_SA(1, 0), a3, voffA);
            PG8_WAIT_V(8); PG8_WAIT_L(0); PG8_BAR; PG8_MMA(1, 0, At, B0); PG8_MMA(1, 1, At, B1); PG8_BAR; PG8_SCHED;
            } else {
            PG8_LDB(B0, 0, 0); PG8_SCHED; PG8_LDA(At, 0, 0); PG8_STAGE(PG8_SA(1, 1), a1 + hstepA, voffA);
            PG8_WAIT_L(8); PG8_BAR; PG8_WAIT_L(0); PG8_MMA(0, 0, At, B0); PG8_BAR; PG8_SCHED;
            PG8_LDB(B1, 0, 1); PG8_STAGE(PG8_SB(0, 0), b2, voffB);
            PG8_BAR; PG8_WAIT_L(0); PG8_MMA(0, 1, At, B1); PG8_BAR;
            PG8_LDA(At, 0, 1); PG8_STAGE(PG8_SA(0, 0), a2, voffA);
            PG8_BAR; PG8_WAIT_L(0); PG8_MMA(1, 0, At, B0); PG8_BAR; PG8_SCHED;
            PG8_STAGE(PG8_SB(0, 1), b2 + hstepB, voffB);
            PG8_WAIT_V(6); PG8_BAR; PG8_MMA(1, 1, At, B1); PG8_BAR;
            PG8_LDB(B0, 1, 0); PG8_SCHED; PG8_LDA(At, 1, 0); PG8_STAGE(PG8_SA(0, 1), a2 + hstepA, voffA);
            PG8_WAIT_L(8); PG8_BAR; PG8_WAIT_L(0); PG8_MMA(0, 0, At, B0); PG8_BAR; PG8_SCHED;
            PG8_LDB(B1, 1, 1); PG8_STAGE(PG8_SB(1, 0), b3, voffB);
            PG8_BAR; PG8_WAIT_L(0); PG8_MMA(0, 1, At, B1); PG8_BAR;
            PG8_LDA(At, 1, 1); PG8_STAGE(PG8_SA(1, 0), a3, voffA);
            PG8_BAR; PG8_WAIT_L(0); PG8_MMA(1, 0, At, B0); PG8_BAR; PG8_SCHED;
            PG8_STAGE(PG8_SB(1, 1), b3 + hstepB, voffB);
            PG8_WAIT_V(6); PG8_BAR; PG8_MMA(1, 1, At, B1); PG8_BAR;
            }
        }
        if constexpr (ALIGN_EPI) { if (wr == 0) PG8_BAR; }
        if constexpr (!Epi::AFTER_DRAIN) { E(acc, cur, wr, wc, fr, fq); S.done(cur); }
        if (!has_next) break;
#pragma unroll
        for (int a = 0; a < 2; ++a)
#pragma unroll
            for (int b = 0; b < 2; ++b)
#pragma unroll
                for (int m = 0; m < 4; ++m)
#pragma unroll
                    for (int n = 0; n < 2; ++n) acc[a][b][m][n] = (f32x4){0.f, 0.f, 0.f, 0.f};
        cur = nxt; cA = nA; cB = nB; ++ui;
        if constexpr (ALIGN_EPI) { if (wr == 1) PG8_BAR; }
    }
    PG8_WAIT_V(0);
    if constexpr (!ALIGN_EPI) { if (wr == 0) PG8_BAR; }
    PG8_BAR;
    if constexpr (Epi::AFTER_DRAIN) { E.fused(acc, cur, wr, wc, fr, fq, lds, wid, lane); S.done(cur); }
#undef PG8_SA
#undef PG8_SB
#undef PG8_STAGE
#undef PG8_LDA
#undef PG8_LDB
#undef PG8_MMA
#undef PG8_WAIT_V
#undef PG8_WAIT_L
#undef PG8_BAR
#undef PG8_SCHED
}
}

#define LAS __attribute__((address_space(3)))
typedef unsigned short bf16;
typedef unsigned u32x4 __attribute__((ext_vector_type(4)));
typedef unsigned u32x2 __attribute__((ext_vector_type(2)));
typedef float f32x4 __attribute__((ext_vector_type(4)));
typedef float f32x16 __attribute__((ext_vector_type(16)));
typedef short bf16x8 __attribute__((ext_vector_type(8)));

constexpr int NB = 8, NT = 4096, DM = 1024, MROWS = NB * NT, FF = 4096, DPLE = 256, NINP = 2560;
constexpr float EPS = 1e-6f;
constexpr float LOG2E = 1.4426950408889634f;
constexpr float QSCALE = 0.125f * LOG2E;
constexpr size_t MiB = (size_t)1 << 20;
constexpr size_t WS_BAR = 512 * 1024, WS_WSB = 640 * 1024;
constexpr size_t WS_BAR_ = 0;
constexpr size_t WS_B1P = 0, WS_WIN = 1 * MiB, WS_WO = 6 * MiB, WS_W1 = 8 * MiB, WS_W2 = 16 * MiB, WS_WG = 24 * MiB, WS_WP = 26 * MiB,
                 WS_WC1K = 27 * MiB, WS_WC1V = 28 * MiB, WS_RSS1 = 29 * MiB, WS_RSS2 = 31 * MiB, WS_XB = 34 * MiB, WS_PB = 98 * MiB,
                 WS_TP = 114 * MiB, WS_BIG = 178 * MiB;
constexpr size_t WS_H1 = WS_BIG, WS_ZQ = WS_BIG, WS_ZU = WS_BIG + 32 * MiB, WS_ZV = WS_BIG + 64 * MiB, WS_MIX = WS_BIG + 96 * MiB,
                 WS_KV = WS_BIG + 160 * MiB, KV_STRIDE_B = 9 * MiB, WS_GATES = WS_BIG + 214 * MiB, WS_HDNK = WS_BIG + 217 * MiB,
                 WS_HDNV = WS_BIG + 219 * MiB, WS_KC = WS_BIG + 250 * MiB, WS_VC = WS_BIG + 251 * MiB;
constexpr size_t KV_STRIDE = KV_STRIDE_B / 2;
constexpr int LDS_BYTES = 147456;

struct Args { const float* in[31]; float* out; unsigned char* ws; };
enum { I_X = 0, I_P, I_GMIX, I_WIN, I_QG, I_KCG, I_KSG, I_KWG, I_POSK, I_POSV, I_CKW1, I_CKB1, I_CKW2, I_CKB2, I_CVW1, I_CVB1, I_CVW2, I_CVB2,
       I_LNG, I_LNB, I_GWS, I_GBS, I_OGN, I_OGG, I_WOUT, I_GFF, I_WFF1, I_WFF2, I_GPLE, I_WPG, I_WPLE };

__device__ __forceinline__ unsigned f2bf(float f) { unsigned u = __builtin_bit_cast(unsigned, f); return (u + 0x7fffu + ((u >> 16) & 1u)) >> 16; }
typedef __bf16 bf16x2_t __attribute__((ext_vector_type(2))); typedef float f32x2_t __attribute__((ext_vector_type(2)));
__device__ __forceinline__ unsigned pk2(float lo, float hi) { return f2bf(lo) | (f2bf(hi) << 16); }
__device__ __forceinline__ unsigned pk2_hw(float lo, float hi) { f32x2_t v = {lo, hi}; bf16x2_t b = __builtin_convertvector(v, bf16x2_t); return __builtin_bit_cast(unsigned, b); }
__device__ __forceinline__ float bflo(unsigned u) { return __builtin_bit_cast(float, u << 16); }
__device__ __forceinline__ float bfhi(unsigned u) { return __builtin_bit_cast(float, u & 0xffff0000u); }
__device__ __forceinline__ float wave_sum(float v) {
    v += __builtin_bit_cast(float, __builtin_amdgcn_update_dpp(0, __builtin_bit_cast(int, v), 0xB1, 0xf, 0xf, false));
    v += __builtin_bit_cast(float, __builtin_amdgcn_update_dpp(0, __builtin_bit_cast(int, v), 0x4E, 0xf, 0xf, false));
    v += __builtin_bit_cast(float, __builtin_amdgcn_update_dpp(0, __builtin_bit_cast(int, v), 0x141, 0xf, 0xf, false));
    v += __builtin_bit_cast(float, __builtin_amdgcn_update_dpp(0, __builtin_bit_cast(int, v), 0x140, 0xf, 0xf, false));
    v += __builtin_bit_cast(float, __builtin_amdgcn_update_dpp(0, __builtin_bit_cast(int, v), 0x142, 0xa, 0xf, false));
    v += __builtin_bit_cast(float, __builtin_amdgcn_update_dpp(0, __builtin_bit_cast(int, v), 0x143, 0xc, 0xf, false));
    return __builtin_bit_cast(float, __builtin_amdgcn_readlane(__builtin_bit_cast(int, v), 63));
}
__device__ __forceinline__ float gelu_tanh(float x) {
    const float u = x + 0.044715f * x * x * x;
    const float e = __builtin_amdgcn_exp2f(-2.3022082f * u);
    return x * __builtin_amdgcn_rcpf(1.0f + e);
}
__device__ __forceinline__ float sigmoidf_(float x) { return __builtin_amdgcn_rcpf(1.0f + __builtin_amdgcn_exp2f(-LOG2E * x)); }
__device__ __forceinline__ u32x4 pack8(f32x4 a, f32x4 b) { u32x4 w; w.x = pk2(a[0], a[1]); w.y = pk2(a[2], a[3]); w.z = pk2(b[0], b[1]); w.w = pk2(b[2], b[3]); return w; }
__device__ __forceinline__ u32x4 pack8_hw(f32x4 a, f32x4 b) { u32x4 w; w.x = pg8::cvt_pk_bf16(a[0], a[1]); w.y = pg8::cvt_pk_bf16(a[2], a[3]); w.z = pg8::cvt_pk_bf16(b[0], b[1]); w.w = pg8::cvt_pk_bf16(b[2], b[3]); return w; }

template <class F> struct EpiRow {
    static constexpr bool PERM = true, AFTER_DRAIN = false;
    F f;
    __device__ __forceinline__ void operator()(const pg8::f32x4 (&acc)[2][2][4][2], const pg8::Unit& u, int wr, int wc, int fr, int fq) const {
        const int c0 = u.pn * 256 + wc * 32 + 8 * fq;
#pragma unroll
        for (int ai = 0; ai < 2; ++ai)
#pragma unroll
            for (int m = 0; m < 4; ++m) {
                const int row = u.pm * 256 + ai * 128 + wr * 64 + m * 16 + fr;
                f(row, c0, u.pn * 4 + wc, acc[ai][0][m][0], acc[ai][0][m][1], acc[ai][1][m][0], acc[ai][1][m][1]);
            }
    }
};

template <class F> struct EpiRowP {
    static constexpr bool PERM = true, AFTER_DRAIN = false;
    F f;
    __device__ __forceinline__ void operator()(const pg8::f32x4 (&acc)[2][2][4][2], const pg8::Unit& u, int wr, int wc, int fr, int fq) const {
        const int c0 = u.pn * 256 + wc * 32 + 8 * fq, rbase = u.pm * 256 + wr * 64 + fr;
        typename F::Pre nx = f.pre(rbase, c0);
#pragma unroll
        for (int idx = 0; idx < 8; ++idx) {
            const int ai = idx >> 2, m = idx & 3, row = rbase + ai * 128 + m * 16;
            const typename F::Pre cur = nx;
            if (idx < 7) nx = f.pre(rbase + ((idx + 1) >> 2) * 128 + ((idx + 1) & 3) * 16, c0);
            f(row, c0, u.pn * 4 + wc, acc[ai][0][m][0], acc[ai][0][m][1], acc[ai][1][m][0], acc[ai][1][m][1], cur);
        }
    }
};
struct Pre4 { f32x4 v[4]; };
__device__ __forceinline__ float rinv_from(const Pre4& p) {
    const float s = ((p.v[0][0] + p.v[0][1]) + (p.v[0][2] + p.v[0][3])) + ((p.v[1][0] + p.v[1][1]) + (p.v[1][2] + p.v[1][3])) + ((p.v[2][0] + p.v[2][1]) + (p.v[2][2] + p.v[2][3])) + ((p.v[3][0] + p.v[3][1]) + (p.v[3][2] + p.v[3][3]));
    return __builtin_amdgcn_rsqf(s * (1.0f / DM) + EPS);
}
struct FIn {
    bf16* zq; bf16* kv; bf16* zu; bf16* zv; float* gates;
    __device__ __forceinline__ void one(int row, int col, f32x4 v0, f32x4 v1) const {
        if (col < 512) { *(u32x4*)(zq + (size_t)row * 512 + col) = pack8_hw(v0, v1); }
        else if (col < 1280) { const int cc = col - 512, seg = cc >> 7, w = cc & 127, g = w >> 6, d = w & 63, b = row >> 12, t = row & 4095;
            if (seg == 3 || seg == 5) {
                bf16* vt = kv + (size_t)seg * KV_STRIDE + ((size_t)(b * 2 + g) * 4096 + (t & ~63)) * 64 + (size_t)d * 64 + (t & 63);
                const u32x4 pk = pack8_hw(v0, v1);
                vt[0 * 64] = (bf16)(pk.x & 0xffff); vt[1 * 64] = (bf16)(pk.x >> 16); vt[2 * 64] = (bf16)(pk.y & 0xffff); vt[3 * 64] = (bf16)(pk.y >> 16);
                vt[4 * 64] = (bf16)(pk.z & 0xffff); vt[5 * 64] = (bf16)(pk.z >> 16); vt[6 * 64] = (bf16)(pk.w & 0xffff); vt[7 * 64] = (bf16)(pk.w >> 16);
            } else
            *(u32x4*)(kv + (size_t)seg * KV_STRIDE + (((size_t)(b * 2 + g) * 4096 + t) * 64 + d)) = pack8_hw(v0, v1); }
        else if (col < 2304) { const int cc = col - 1280;
#pragma unroll
            for (int i = 0; i < 4; ++i) { v0[i] = gelu_tanh(v0[i]); v1[i] = gelu_tanh(v1[i]); }
            bf16* dst = cc < 512 ? zu + (size_t)row * 512 + cc : zv + (size_t)row * 512 + (cc - 512);
            *(u32x4*)dst = pack8_hw(v0, v1); }
        else if (col < 2328) {
#pragma unroll
            for (int i = 0; i < 4; ++i) { v0[i] = sigmoidf_(v0[i]); v1[i] = sigmoidf_(v1[i]); }
            float* dst = gates + (size_t)row * 24 + (col - 2304);
            *(f32x4*)dst = v0; *(f32x4*)(dst + 4) = v1; }
    }
    __device__ __forceinline__ void operator()(int row, int c0, int, f32x4 a0, f32x4 a1, f32x4 b0, f32x4 b1) const { one(row, c0, a0, a1); one(row, c0 + 128, b0, b1); }
};
struct FPlain { bf16* O; int ldc;
    __device__ __forceinline__ void operator()(int row, int c0, int, f32x4 a0, f32x4 a1, f32x4 b0, f32x4 b1) const {
        bf16* p = O + (size_t)row * ldc + c0; *(u32x4*)p = pack8(a0, a1); *(u32x4*)(p + 128) = pack8(b0, b1); }
};
struct FPart { float* O;
    __device__ __forceinline__ void operator()(int row, int c0, int, f32x4 a0, f32x4 a1, f32x4 b0, f32x4 b1) const {
        float* p = O + (size_t)row * 256 + c0; *(f32x4*)p = a0; *(f32x4*)(p + 4) = a1; *(f32x4*)(p + 128) = b0; *(f32x4*)(p + 132) = b1; }
};
struct FCmp { bf16* O; const float* b1p;
    __device__ __forceinline__ void operator()(int row, int c0, int, f32x4 a0, f32x4 a1, f32x4 b0, f32x4 b1) const {
        const f32x4 ba0 = *(const f32x4*)(b1p + c0), ba1 = *(const f32x4*)(b1p + c0 + 4), bb0 = *(const f32x4*)(b1p + c0 + 128), bb1 = *(const f32x4*)(b1p + c0 + 132);
#pragma unroll
        for (int i = 0; i < 4; ++i) { a0[i] = gelu_tanh(a0[i] + ba0[i]); a1[i] = gelu_tanh(a1[i] + ba1[i]); b0[i] = gelu_tanh(b0[i] + bb0[i]); b1[i] = gelu_tanh(b1[i] + bb1[i]); }
        bf16* p = O + (size_t)row * 256 + c0; *(u32x4*)p = pack8(a0, a1); *(u32x4*)(p + 128) = pack8(b0, b1); }
};
__device__ __forceinline__ float sumsq8(f32x4 a, f32x4 b) { return (a[0] * a[0] + a[1] * a[1]) + (a[2] * a[2] + a[3] * a[3]) + (b[0] * b[0] + b[1] * b[1]) + (b[2] * b[2] + b[3] * b[3]); }
struct FResA {
    const float* xi; bf16* xb; float* rss;
    typedef Pre4 Pre;
    __device__ __forceinline__ Pre pre(int row, int c0) const { const float* xp = xi + (size_t)row * DM + c0; Pre p; p.v[0] = *(const f32x4*)xp; p.v[1] = *(const f32x4*)(xp + 4); p.v[2] = *(const f32x4*)(xp + 128); p.v[3] = *(const f32x4*)(xp + 132); return p; }
    __device__ __forceinline__ void operator()(int row, int c0, int slot, f32x4 a0, f32x4 a1, f32x4 b0, f32x4 b1, const Pre& p) const {
        a0 += p.v[0]; a1 += p.v[1]; b0 += p.v[2]; b1 += p.v[3];
        bf16* bp = xb + (size_t)row * DM + c0; *(u32x4*)bp = pack8_hw(a0, a1); *(u32x4*)(bp + 128) = pack8_hw(b0, b1);
        float s = sumsq8(a0, a1) + sumsq8(b0, b1);
        s += __shfl_xor(s, 16); s += __shfl_xor(s, 32);
        if ((threadIdx.x & 63) < 16) rss[(size_t)row * 16 + slot] = s;
    }
};
struct PreB { u32x4 a, b; };
struct FResB {
    float* xo; bf16* xb; float* rss;
    typedef PreB Pre;
    __device__ __forceinline__ Pre pre(int row, int c0) const { const bf16* xp = xb + (size_t)row * DM + c0; Pre p; p.a = *(const u32x4*)xp; p.b = *(const u32x4*)(xp + 128); return p; }
    __device__ __forceinline__ void operator()(int row, int c0, int slot, f32x4 a0, f32x4 a1, f32x4 b0, f32x4 b1, const Pre& p) const {
        a0[0] += bflo(p.a.x); a0[1] += bfhi(p.a.x); a0[2] += bflo(p.a.y); a0[3] += bfhi(p.a.y); a1[0] += bflo(p.a.z); a1[1] += bfhi(p.a.z); a1[2] += bflo(p.a.w); a1[3] += bfhi(p.a.w);
        b0[0] += bflo(p.b.x); b0[1] += bfhi(p.b.x); b0[2] += bflo(p.b.y); b0[3] += bfhi(p.b.y); b1[0] += bflo(p.b.z); b1[1] += bfhi(p.b.z); b1[2] += bflo(p.b.w); b1[3] += bfhi(p.b.w);
        float* op = xo + (size_t)row * DM + c0;
        *(f32x4*)op = a0; *(f32x4*)(op + 4) = a1; *(f32x4*)(op + 128) = b0; *(f32x4*)(op + 132) = b1;
        bf16* bp = xb + (size_t)row * DM + c0; *(u32x4*)bp = pack8_hw(a0, a1); *(u32x4*)(bp + 128) = pack8_hw(b0, b1);
        float s = sumsq8(a0, a1) + sumsq8(b0, b1);
        s += __shfl_xor(s, 16); s += __shfl_xor(s, 32);
        if ((threadIdx.x & 63) < 16) rss[(size_t)row * 16 + slot] = s;
    }
};
__device__ __forceinline__ float row_rinv(const float* rss, int row) {
    const f32x4* p = (const f32x4*)(rss + (size_t)row * 16);
    const f32x4 a = p[0], b = p[1], c = p[2], d = p[3];
    const float s = ((a[0] + a[1]) + (a[2] + a[3])) + ((b[0] + b[1]) + (b[2] + b[3])) + ((c[0] + c[1]) + (c[2] + c[3])) + ((d[0] + d[1]) + (d[2] + d[3]));
    return __builtin_amdgcn_rsqf(s * (1.0f / DM) + EPS);
}
struct FFF1 { bf16* H; const float* rss;
    typedef Pre4 Pre;
    __device__ __forceinline__ Pre pre(int row, int) const { const f32x4* q = (const f32x4*)(rss + (size_t)row * 16); Pre p; p.v[0] = q[0]; p.v[1] = q[1]; p.v[2] = q[2]; p.v[3] = q[3]; return p; }
    __device__ __forceinline__ void operator()(int row, int c0, int, f32x4 a0, f32x4 a1, f32x4 b0, f32x4 b1, const Pre& pp) const {
        const float r = rinv_from(pp);
#pragma unroll
        for (int i = 0; i < 4; ++i) { float t;
            t = fmaxf(a0[i] * r, 0.f); a0[i] = t * t; t = fmaxf(a1[i] * r, 0.f); a1[i] = t * t;
            t = fmaxf(b0[i] * r, 0.f); b0[i] = t * t; t = fmaxf(b1[i] * r, 0.f); b1[i] = t * t; }
        bf16* p = H + (size_t)row * FF + c0; *(u32x4*)p = pack8_hw(a0, a1); *(u32x4*)(p + 128) = pack8_hw(b0, b1); }
};
struct FGate { float* xo; const bf16* tp; const float* rss;
    __device__ __forceinline__ void operator()(int row, int c0, int, f32x4 a0, f32x4 a1, f32x4 b0, f32x4 b1) const {
        const float r = row_rinv(rss, row);
        float* op = xo + (size_t)row * DM + c0;
        const u32x4 ta = *(const u32x4*)(tp + (size_t)row * DM + c0), tb = *(const u32x4*)(tp + (size_t)row * DM + c0 + 128);
        f32x4 x0 = *(f32x4*)op, x1 = *(f32x4*)(op + 4), y0 = *(f32x4*)(op + 128), y1 = *(f32x4*)(op + 132);
        x0[0] += sigmoidf_(a0[0] * r) * bflo(ta.x); x0[1] += sigmoidf_(a0[1] * r) * bfhi(ta.x); x0[2] += sigmoidf_(a0[2] * r) * bflo(ta.y); x0[3] += sigmoidf_(a0[3] * r) * bfhi(ta.y);
        x1[0] += sigmoidf_(a1[0] * r) * bflo(ta.z); x1[1] += sigmoidf_(a1[1] * r) * bfhi(ta.z); x1[2] += sigmoidf_(a1[2] * r) * bflo(ta.w); x1[3] += sigmoidf_(a1[3] * r) * bfhi(ta.w);
        y0[0] += sigmoidf_(b0[0] * r) * bflo(tb.x); y0[1] += sigmoidf_(b0[1] * r) * bfhi(tb.x); y0[2] += sigmoidf_(b0[2] * r) * bflo(tb.y); y0[3] += sigmoidf_(b0[3] * r) * bfhi(tb.y);
        y1[0] += sigmoidf_(b1[0] * r) * bflo(tb.z); y1[1] += sigmoidf_(b1[1] * r) * bfhi(tb.z); y1[2] += sigmoidf_(b1[2] * r) * bflo(tb.w); y1[3] += sigmoidf_(b1[3] * r) * bfhi(tb.w);
        *(f32x4*)op = x0; *(f32x4*)(op + 4) = x1; *(f32x4*)(op + 128) = y0; *(f32x4*)(op + 132) = y1;
    }
};
struct TpDeal {
    int bx, G;
    __device__ __forceinline__ bool next(int i, pg8::Unit& u) const {
        int k;
        if (G == 256) { if (bx < 128) { if (i != 0) return false; k = bx; } else { if (i >= 3) return false; k = 128 + (bx - 128) * 3 + i; } }
        else { k = bx + i * G; if (k >= 512) return false; }
        u.pm = k >> 2; u.pn = k & 3; return true;
    }
    __device__ __forceinline__ void a_ready(const pg8::Unit&) const {}
    __device__ __forceinline__ void done(const pg8::Unit&) const {}
};
struct OneUnit {
    int pm;
    __device__ __forceinline__ bool next(int i, pg8::Unit& u) const { if (i != 0 || pm < 0) return false; u.pm = pm; u.pn = 0; return true; }
    __device__ __forceinline__ void a_ready(const pg8::Unit&) const {}
    __device__ __forceinline__ void done(const pg8::Unit&) const {}
};

__device__ __forceinline__ void tr_item(const float* W, int ldw, int k0, int n0, bf16* WT, int ldt, int row0, const float* gain, LAS float* scr, int lane) {
#pragma unroll 8
    for (int i = 0; i < 32; ++i) { const int kk = 2 * i + (lane >> 5); float v = W[(size_t)(k0 + kk) * ldw + n0 + (lane & 31)]; if (gain) v *= gain[k0 + kk]; scr[kk * 33 + (lane & 31)] = v; }
    asm volatile("s_waitcnt lgkmcnt(0)" ::: "memory");
    const int c = lane & 7;
#pragma unroll
    for (int j = 0; j < 4; ++j) { const int n = (lane >> 3) + 8 * j; const LAS float* s = scr + (8 * c) * 33 + n;
        u32x4 o; o.x = pk2(s[0 * 33], s[1 * 33]); o.y = pk2(s[2 * 33], s[3 * 33]); o.z = pk2(s[4 * 33], s[5 * 33]); o.w = pk2(s[6 * 33], s[7 * 33]);
        *(u32x4*)(WT + (size_t)(row0 + n) * ldt + k0 + 8 * c) = o; }
    asm volatile("s_waitcnt lgkmcnt(0)" ::: "memory");
}

namespace att {
constexpr int KROW = 144, VROW = 136, KSZ = 64 * KROW, VSZ = 64 * VROW, BUFSZ = KSZ + VSZ;
constexpr int OFF_K = 0, OFF_V = KSZ, OFF_IMP = 2 * BUFSZ, IMPW = 8 * 65 * 4, OFF_RS = OFF_IMP + 8 * IMPW, OFF_UM = OFF_RS + 512, OFF_TL = OFF_UM + 64, OFF_TN = OFF_TL + 512, OFF_Q = OFF_TN + 64, OFF_STG = OFF_Q + 8 * 4096, ATT_END = OFF_STG + 8 * 4096;
static_assert(ATT_END <= 147456 && OFF_Q % 16 == 0 && OFF_IMP % 16 == 0 && BUFSZ % 16 == 0, "attention LDS");
}
#define XB_TMO      128
#define XB_XCNT(j)  (256  + 64 * (j))
#define XB_XSUB(j)  (1280 + 64 * (j))
#define XB_XGEN(j)  (2304 + 64 * (j))
#define XB_TOP      3328
#define XB_TOPGEN   3392
#define XCD_BAR_WORDS 3456
#define XB_SPIN_CAP (1u << 22)

__device__ __forceinline__ unsigned xb_ld(unsigned* p)              { return __hip_atomic_load(p, __ATOMIC_RELAXED, __HIP_MEMORY_SCOPE_AGENT); }
__device__ __forceinline__ unsigned xb_add(unsigned* p, unsigned v) { return __hip_atomic_fetch_add(p, v, __ATOMIC_RELAXED, __HIP_MEMORY_SCOPE_AGENT); }
__device__ __forceinline__ unsigned xb_xcc_id() { return (unsigned)__builtin_amdgcn_s_getreg((3 << 11) | 20) & 0xFu; }
#define XB_SPIN(cond, bar) do { unsigned _sp = 0; while (cond) { __builtin_amdgcn_s_sleep(1); \
    if ((++_sp & 255u) == 0u) { if (xb_ld(&(bar)[XB_TMO])) break; if (_sp > XB_SPIN_CAP) { atomicAdd(&(bar)[XB_TMO], 1u); break; } } } } while (0)

struct XcdBarrier {
    unsigned* bar; unsigned x;
    volatile LAS unsigned* st;
};

__device__ __forceinline__ XcdBarrier xcd_barrier_post(unsigned* bar, volatile LAS unsigned* st) {
    XcdBarrier b; b.bar = bar; b.x = xb_xcc_id(); b.st = st;
    if (threadIdx.x == 0) (void)xb_add(&bar[XB_XCNT(b.x)], 1u);
    return b;
}
__device__ __forceinline__ void xcd_barrier_complete(unsigned* bar, unsigned x, unsigned& nloc, unsigned& nx) {
    const unsigned G = gridDim.x * gridDim.y * gridDim.z;
    unsigned sum, cnt, mine, sp = 0u;
    for (;;) {
        sum = 0u; cnt = 0u; mine = 0u;
#pragma unroll
        for (unsigned j = 0; j < 16; ++j) { const unsigned c = xb_ld(&bar[XB_XCNT(j)]); sum += c; cnt += (c > 0u) ? 1u : 0u; mine = (j == x) ? c : mine; }
        if (sum == G) break;
        __builtin_amdgcn_s_sleep(1);
        if ((++sp & 255u) == 0u) { if (xb_ld(&bar[XB_TMO])) break; if (sp > XB_SPIN_CAP) { atomicAdd(&bar[XB_TMO], 1u); break; } }
    }
    nloc = mine > 0u ? mine : 1u; nx = cnt > 0u ? cnt : 1u;
}

__device__ __forceinline__ void xcd_barrier(const XcdBarrier& b) {
    asm volatile("s_waitcnt vmcnt(0)" ::: "memory");
    __syncthreads();
    if (threadIdx.x == 0) {
        unsigned* bar = b.bar;
        __builtin_amdgcn_s_waitcnt(0);
        unsigned nloc = b.st[0], nx = b.st[1];
        if (nloc == 0u) { xcd_barrier_complete(bar, b.x, nloc, nx); b.st[0] = nloc; b.st[1] = nx; }
        const unsigned old = xb_add(&bar[XB_XSUB(b.x)], 1u);
        const unsigned gen = old / nloc;
        if (old + 1u == (gen + 1u) * nloc) {
            __builtin_amdgcn_fence(__ATOMIC_RELEASE, "agent");
            asm volatile("s_waitcnt vmcnt(0)" ::: "memory");
            const unsigned og = xb_add(&bar[XB_TOP], 1u);
            const unsigned tg = og / nx;
            if (og + 1u == (tg + 1u) * nx) xb_add(&bar[XB_TOPGEN], 1u);
            else XB_SPIN(xb_ld(&bar[XB_TOPGEN]) == tg, bar);
            __builtin_amdgcn_fence(__ATOMIC_ACQUIRE, "agent");
            xb_add(&bar[XB_XGEN(b.x)], 1u);
            asm volatile("s_waitcnt vmcnt(0)" ::: "memory");
        } else {
            XB_SPIN(xb_ld(&bar[XB_XGEN(b.x)]) == gen, bar);
            __builtin_amdgcn_fence(__ATOMIC_ACQUIRE, "agent");
            asm volatile("s_waitcnt vmcnt(0)" ::: "memory");
        }
    }
    __syncthreads();
}

namespace att {
#define NEG_INF (-__builtin_inff())
#define SBAR_() __builtin_amdgcn_sched_barrier(0)
__device__ __forceinline__ float rowmax32(const f32x16 (&s)[2]) {
    float mx = s[0][0];
#pragma unroll
    for (int kb = 0; kb < 2; ++kb)
#pragma unroll
        for (int i = 0; i < 16; ++i) mx = fmaxf(mx, s[kb][i]);
    return fmaxf(mx, __shfl_xor(mx, 32));
}
typedef float f32x2v __attribute__((ext_vector_type(2)));
__device__ __forceinline__ float exp_sub_sum(f32x16 (&s)[2], float c) {
    const f32x2v cc = {c, c}; f32x2v acc = {0.f, 0.f};
#pragma unroll
    for (int kb = 0; kb < 2; ++kb)
#pragma unroll
        for (int i = 0; i < 16; i += 2) {
            f32x2v d = {s[kb][i], s[kb][i + 1]}; d = d - cc;
            f32x2v p; p.x = __builtin_amdgcn_exp2f(d.x); p.y = __builtin_amdgcn_exp2f(d.y);
            s[kb][i] = p.x; s[kb][i + 1] = p.y; acc = acc + p;
        }
    return acc.x + acc.y;
}
__device__ __forceinline__ void exp_sub_scale(f32x16 (&s)[2], float c, float sc) {
    const f32x2v cc = {c, c}, ss = {sc, sc};
#pragma unroll
    for (int kb = 0; kb < 2; ++kb)
#pragma unroll
        for (int i = 0; i < 16; i += 2) {
            f32x2v d = {s[kb][i], s[kb][i + 1]}; d = d - cc;
            f32x2v p; p.x = __builtin_amdgcn_exp2f(d.x); p.y = __builtin_amdgcn_exp2f(d.y); p = p * ss;
            s[kb][i] = p.x; s[kb][i + 1] = p.y;
        }
}
__device__ __forceinline__ void stats_update(f32x16 (&s)[2], float& m, float& l, float base) {
    const float mx = rowmax32(s) + base, mn = fmaxf(m, mx), mu = (mn == NEG_INF) ? 0.f : mn;
    const float alpha = __builtin_amdgcn_exp2f(m - mu), c = mu - base;
    const float sum = exp_sub_sum(s, c);
    l = l * alpha + sum; m = mn;
}
template <int MUL, bool CAUSAL, bool LOWER>
__device__ __forceinline__ void scores(f32x16 (&s)[2], const bf16x8 qx, const LAS unsigned char* qL, const LAS unsigned char* Kg, int l32, int hi, int limHi, int limLo) {
    bf16x8 q[4];
#pragma unroll
    for (int ks = 0; ks < 4; ++ks) q[ks] = *(const LAS bf16x8*)(qL + ks * 1024);
    __builtin_amdgcn_s_setprio(1);
#pragma unroll
    for (int kb = 0; kb < 2; ++kb) {
        f32x16 a;
        {
            const unsigned kl = (hi == 0) ? (unsigned)__builtin_bit_cast(unsigned short, (__bf16)(float)(kb * 32 + l32)) * 0x10001u : 0u;
            u32x4 kw; kw.x = kl; kw.y = 0u; kw.z = 0u; kw.w = 0u;
            f32x16 z;
#pragma unroll
            for (int i = 0; i < 16; ++i) z[i] = 0.f;
            a = __builtin_amdgcn_mfma_f32_32x32x16_bf16(__builtin_bit_cast(bf16x8, kw), qx, z, 0, 0, 0);
        }
#pragma unroll
        for (int ks = 0; ks < 4; ++ks) {
            const bf16x8 kf = *(const LAS bf16x8*)(Kg + (kb * 32 + l32) * KROW + ks * 32 + hi * 16);
            a = __builtin_amdgcn_mfma_f32_32x32x16_bf16(kf, q[ks], a, 0, 0, 0);
        }
        if (CAUSAL || LOWER) {
#pragma unroll
            for (int i = 0; i < 16; ++i) {
                const int ci = kb * 32 + (i & 3) + 8 * (i >> 2);
                if (CAUSAL) { if (ci * MUL > limHi) a[i] = NEG_INF; }
                if (LOWER) { if (ci <= limLo) a[i] = NEG_INF; }
            }
        }
        s[kb] = a;
    }
    __builtin_amdgcn_s_setprio(0);
}
__device__ __forceinline__ bf16x8 make_qx(float slope, int hi) {
    const __bf16 h = (__bf16)slope; const __bf16 lo = (__bf16)(slope - (float)h);
    const unsigned v = (unsigned)__builtin_bit_cast(unsigned short, h) | ((unsigned)__builtin_bit_cast(unsigned short, lo) << 16);
    u32x4 w; w.x = (hi == 0) ? v : 0u; w.y = 0u; w.z = 0u; w.w = 0u;
    return __builtin_bit_cast(bf16x8, w);
}
__device__ __forceinline__ void online(f32x16 (&s)[2], f32x16 (&o)[2], float& m, float& l, float base) {
    const float mx = rowmax32(s) + base, mn = fmaxf(m, mx), mu = (mn == NEG_INF) ? 0.f : mn;
    const float alpha = __builtin_amdgcn_exp2f(m - mu), c = mu - base;
    const float sum = exp_sub_sum(s, c);
    l = l * alpha + sum; m = mn;
    if (__builtin_amdgcn_ballot_w64(alpha != 1.0f) != 0ull) {
#pragma unroll
        for (int db = 0; db < 2; ++db)
#pragma unroll
            for (int i = 0; i < 16; ++i) o[db][i] *= alpha;
    }
}
__device__ __forceinline__ void pack_p(bf16x8 (&pk)[4], const f32x16 (&s)[2]) {
#pragma unroll
    for (int kk = 0; kk < 4; ++kk) {
        const int kb = kk >> 1, i0 = (kk & 1) * 8;
        u32x4 w; w.x = pk2_hw(s[kb][i0], s[kb][i0 + 1]); w.y = pk2_hw(s[kb][i0 + 2], s[kb][i0 + 3]); w.z = pk2_hw(s[kb][i0 + 4], s[kb][i0 + 5]); w.w = pk2_hw(s[kb][i0 + 6], s[kb][i0 + 7]);
        pk[kk] = __builtin_bit_cast(bf16x8, w);
    }
}
__device__ __forceinline__ void pv(f32x16 (&o)[2], const bf16x8 (&pk)[4], const LAS unsigned char* Vg, int l32, int hi) {
    __builtin_amdgcn_s_setprio(1);
#pragma unroll
    for (int db = 0; db < 2; ++db)
#pragma unroll
        for (int kk = 0; kk < 4; ++kk) {
            const LAS unsigned char* p = Vg + (db * 32 + l32) * VROW + (kk * 16 + hi * 4) * 2;
            const u32x2 lo = *(const LAS u32x2*)p, hh = *(const LAS u32x2*)(p + 16);
            u32x4 w; w.x = lo.x; w.y = lo.y; w.z = hh.x; w.w = hh.y;
            const bf16x8 vf = __builtin_bit_cast(bf16x8, w);
            o[db] = __builtin_amdgcn_mfma_f32_32x32x16_bf16(vf, pk[kk], o[db], 0, 0, 0);
        }
    __builtin_amdgcn_s_setprio(0);
}

__device__ __forceinline__ void attn_pass(LAS unsigned char* lds, int b, int qb, int g, const float* qng, const bf16* zq, const bf16* kvb, const bf16* kc, const bf16* vc, const float* gates, bf16* mix) {
    int tid_ = threadIdx.x; asm volatile("" : "+v"(tid_));
    const int tid = tid_, lane = tid & 63, w = __builtin_amdgcn_readfirstlane(tid >> 6), l32_ = lane & 31, hi_ = lane >> 5, qi = lane & 7, hh = l32_ >> 3;
    const int q0 = qb * 64, t = q0 + 8 * w + qi, row = b * 4096 + t, head = g * 4 + hh;
    const size_t gb = (size_t)(b * 2 + g);
    const bf16* ksb = kvb + 2 * KV_STRIDE + gb * 4096 * 64; const bf16* vsb = kvb + 3 * KV_STRIDE + gb * 4096 * 64;
    const bf16* kwb = kvb + 4 * KV_STRIDE + gb * 4096 * 64; const bf16* vwb = kvb + 5 * KV_STRIDE + gb * 4096 * 64;
    const bf16* kcb = kc + gb * 256 * 64; const bf16* vcb = vc + gb * 256 * 64;
    LAS int* TL = (LAS int*)(lds + OFF_TL); LAS int* TN = (LAS int*)(lds + OFF_TN); LAS unsigned* UM = (LAS unsigned*)(lds + OFF_UM); LAS float* SS = (LAS float*)(lds + OFF_RS);
    LAS float* impw = (LAS float*)(lds + OFF_IMP + w * IMPW);
    const int ntc = min(4, (((q0 + 32) >> 4) >> 6) + 1);
    LAS unsigned char* qW_ = lds + OFF_Q + w * 4096 + lane * 16;
    {
        const bf16* qp = zq + (size_t)row * 512 + head * 64 + hi_ * 8;
        u32x4 qv[4]; float ssq = 0.f;
#pragma unroll
        for (int ks = 0; ks < 4; ++ks) { qv[ks] = *(const u32x4*)(qp + ks * 16);
            const float f0 = bflo(qv[ks].x), f1 = bfhi(qv[ks].x), f2 = bflo(qv[ks].y), f3 = bfhi(qv[ks].y), f4 = bflo(qv[ks].z), f5 = bfhi(qv[ks].z), f6 = bflo(qv[ks].w), f7 = bfhi(qv[ks].w);
            ssq += ((f0 * f0 + f1 * f1) + (f2 * f2 + f3 * f3)) + ((f4 * f4 + f5 * f5) + (f6 * f6 + f7 * f7)); }
        ssq += __shfl_xor(ssq, 32);
        const float rq = __builtin_amdgcn_rsqf(ssq * (1.0f / 64.0f) + EPS) * QSCALE;
#pragma unroll
        for (int ks = 0; ks < 4; ++ks) {
            const f32x4 g0 = *(const f32x4*)(qng + ks * 16 + hi_ * 8), g1 = *(const f32x4*)(qng + ks * 16 + hi_ * 8 + 4);
            u32x4 wv;
            wv.x = pk2_hw(bflo(qv[ks].x) * rq * g0[0], bfhi(qv[ks].x) * rq * g0[1]); wv.y = pk2_hw(bflo(qv[ks].y) * rq * g0[2], bfhi(qv[ks].y) * rq * g0[3]);
            wv.z = pk2_hw(bflo(qv[ks].z) * rq * g1[0], bfhi(qv[ks].z) * rq * g1[1]); wv.w = pk2_hw(bflo(qv[ks].w) * rq * g1[2], bfhi(qv[ks].w) * rq * g1[3]);
            *(LAS u32x4*)(qW_ + ks * 1024) = wv;
        }
    }
    const float slope2 = LOG2E / (float)(2 << head);
    if (tid == 0) { int n = 0; for (int j = 0; j < ntc; ++j) TL[n++] = j; for (int j = 0; j < ntc; ++j) TL[n++] = (1 << 8) | j;
        const int j0 = qb >= 8 ? qb - 8 : 0; for (int jw = qb; jw >= j0; --jw) TL[n++] = (4 << 8) | jw; TN[0] = n; }
    __syncthreads();
    f32x16 o[2]; bf16x8 qx;
#pragma unroll
    for (int a = 0; a < 2; ++a)
#pragma unroll
        for (int i = 0; i < 16; ++i) o[a][i] = 0.f;
    qx = make_qx(16.f * slope2, hi_);
    float m = NEG_INF, l = 0.f, mc = 0.f, ilc = 0.f;
    LAS unsigned char* stg = lds + OFF_STG + w * 4096 + lane * 16;
    unsigned sel_lo = 0xffffffffu, sel_hi = 0xffffffffu, un_lo = 0xffffffffu, un_hi = 0xffffffffu;
    const int skey = tid >> 3, spart = tid & 7, soff = skey * 64 + spart * 8;
    u32x4 pfk, pfv;
#define ATT_ISSUE(code) do { const int _k = (code) >> 8, _j = (code) & 255; \
        const bf16* _kp = (_k == 2) ? ksb + (size_t)_j * 4096 : (_k == 4) ? kwb + (size_t)_j * 4096 : kcb + (size_t)_j * 4096; \
        pfk = *(const u32x4*)(_kp + soff); \
        if (_k == 2 || _k == 4 || _k == 1) { const bf16* _vp = (_k == 2) ? vsb + (size_t)_j * 4096 : (_k == 4) ? vwb + (size_t)_j * 4096 : vcb + (size_t)_j * 4096; pfv = *(const u32x4*)(_vp + soff); } } while (0)
#define ATT_COMMIT(code, par) do { const int _k = (code) >> 8; LAS unsigned char* _b = lds + (par) * BUFSZ; \
        *(LAS u32x4*)(_b + OFF_K + skey * KROW + spart * 16) = pfk; \
        if (_k == 2 || _k == 4 || _k == 1) { LAS unsigned char* _d = _b + OFF_V + skey * VROW + spart * 16; \
            u32x2 _lo, _hi; _lo.x = pfv.x; _lo.y = pfv.y; _hi.x = pfv.z; _hi.y = pfv.w; *(LAS u32x2*)_d = _lo; *(LAS u32x2*)(_d + 8) = _hi; } } while (0)
#define ATT_REAL(code) ((code) >= 0 && ((code) >> 8) != 6)

    int idx = 0, n = TN[0], par = 0, prevk = -1;
    { const int c0 = TL[0]; ATT_ISSUE(c0); ATT_COMMIT(c0, 0); const int c1 = TL[1]; ATT_ISSUE(c1); }
    __syncthreads();
    for (;;) {
        const int cur = TL[idx];
        const int kind = cur >> 8, j = cur & 255;
        int l32 = l32_, hi = hi_; asm volatile("" : "+v"(l32), "+v"(hi));
        const LAS unsigned char* qW = qW_;
        const LAS unsigned char* Kg = lds + par * BUFSZ + OFF_K; const LAS unsigned char* Vg = lds + par * BUFSZ + OFF_V;
        if (kind != prevk) {
            if (prevk == 0) {
                const float lt = l + __shfl_xor(l, 32); ilc = lt > 0.f ? 1.0f / lt : 0.f; mc = (m == NEG_INF) ? 0.f : m;
                for (int k = lane; k < 8 * 65; k += 64) impw[k] = 0.f;
            }
            if (kind == 4) {
                {
                const int n_old = n;
                unsigned lo = 0xffffffffu, hw = 0xffffffffu;
                if (qb >= 16) {
                    const int part = lane >> 3;
                    float mine[8]; int rank[8];
#pragma unroll
                    for (int k = 0; k < 8; ++k) { mine[k] = impw[qi * 65 + part * 8 + k]; rank[k] = 0; }
#pragma unroll 4
                    for (int i = 1; i <= qb - 2; ++i) {
                        const float v = impw[qi * 65 + i];
#pragma unroll
                        for (int k = 0; k < 8; ++k) { const int js = part * 8 + k; rank[k] += ((v > mine[k]) || (v == mine[k] && i < js)) ? 1 : 0; }
                    }
                    unsigned bits = 0;
#pragma unroll
                    for (int k = 0; k < 8; ++k) { const int js = part * 8 + k;
                        const bool sel = (js == 0) || (js == qb - 1) || (js == qb) || (js >= 1 && js <= qb - 2 && rank[k] < 13);
                        bits |= sel ? (1u << k) : 0u; }
                    lo = (part < 4) ? (bits << (8 * part)) : 0u;
                    hw = (part >= 4) ? (bits << (8 * (part - 4))) : 0u;
#pragma unroll
                    for (int of = 8; of < 64; of <<= 1) { lo |= __shfl_xor(lo, of); hw |= __shfl_xor(hw, of); }
                }
                sel_lo = lo; sel_hi = hw;
                unsigned ulo = lo, uhi = hw;
#pragma unroll
                for (int of = 1; of < 8; of <<= 1) { ulo |= __shfl_xor(ulo, of); uhi |= __shfl_xor(uhi, of); }
                un_lo = __builtin_amdgcn_readfirstlane(ulo); un_hi = __builtin_amdgcn_readfirstlane(uhi);
                if (lane == 0) { UM[w * 2] = un_lo; UM[w * 2 + 1] = un_hi; }
                __syncthreads();
                if (tid == 0) {
                    unsigned a = 0, c = 0; for (int k = 0; k < 8; ++k) { a |= UM[2 * k]; c |= UM[2 * k + 1]; }
                    int nn = TN[0];
                    for (int js = qb; js >= 0; --js) { const bool on = js < 32 ? ((a >> js) & 1u) : ((c >> (js - 32)) & 1u); if (on) TL[nn++] = (2 << 8) | js; }
                    TN[0] = nn;
                }
                __syncthreads();
                n = TN[0];
                if (idx + 1 >= n_old && idx + 1 < n) { const int c1 = TL[idx + 1]; ATT_ISSUE(c1); }
                }
                qx = make_qx(slope2, hi_);
                const float gc = gates[(size_t)row * 24 + head * 3];
#pragma unroll
                for (int db = 0; db < 2; ++db)
#pragma unroll
                    for (int i4 = 0; i4 < 2; ++i4) {
                        u32x4 wv;
                        wv.x = pk2_hw(o[db][8 * i4 + 0] * gc, o[db][8 * i4 + 1] * gc); wv.y = pk2_hw(o[db][8 * i4 + 2] * gc, o[db][8 * i4 + 3] * gc);
                        wv.z = pk2_hw(o[db][8 * i4 + 4] * gc, o[db][8 * i4 + 5] * gc); wv.w = pk2_hw(o[db][8 * i4 + 6] * gc, o[db][8 * i4 + 7] * gc);
                        *(LAS u32x4*)(stg + (db * 2 + i4) * 1024) = wv;
                    }
#pragma unroll
                for (int db = 0; db < 2; ++db)
#pragma unroll
                    for (int i = 0; i < 16; ++i) o[db][i] = 0.f;
            }
            if (prevk == 4) {
                const float lt = l + __shfl_xor(l, 32); const float sc = lt > 0.f ? gates[(size_t)row * 24 + head * 3 + 2] / lt : 0.f;
#pragma unroll
                for (int db = 0; db < 2; ++db)
#pragma unroll
                    for (int i4 = 0; i4 < 2; ++i4) {
                        const u32x4 pv_ = *(const LAS u32x4*)(stg + (db * 2 + i4) * 1024);
                        u32x4 wv;
                        wv.x = pk2_hw(o[db][8 * i4 + 0] * sc + bflo(pv_.x), o[db][8 * i4 + 1] * sc + bfhi(pv_.x)); wv.y = pk2_hw(o[db][8 * i4 + 2] * sc + bflo(pv_.y), o[db][8 * i4 + 3] * sc + bfhi(pv_.y));
                        wv.z = pk2_hw(o[db][8 * i4 + 4] * sc + bflo(pv_.z), o[db][8 * i4 + 5] * sc + bfhi(pv_.z)); wv.w = pk2_hw(o[db][8 * i4 + 6] * sc + bflo(pv_.w), o[db][8 * i4 + 7] * sc + bfhi(pv_.w));
                        *(LAS u32x4*)(stg + (db * 2 + i4) * 1024) = wv;
                    }
#pragma unroll
                for (int db = 0; db < 2; ++db)
#pragma unroll
                    for (int i = 0; i < 16; ++i) o[db][i] = 0.f;
            }
            m = NEG_INF; l = 0.f;
            prevk = kind;
        }
        const int nxt = (idx + 1 < n) ? TL[idx + 1] : -1;
        if (nxt >= 0) { ATT_COMMIT(nxt, par ^ 1); const int nn = (idx + 2 < n) ? TL[idx + 2] : -1; if (nn >= 0) ATT_ISSUE(nn); }
        if (kind == 0 || kind == 1) {
            f32x16 s[2];
            scores<16, true, false>(s, qx, qW, Kg, l32, hi, t - 31 - 1024 * j - 64 * hi, 0);
            const float base = -slope2 * ((float)(t - 1024 * j - 64 * hi) - 15.5f);
            if (kind == 0) stats_update(s, m, l, base);
            else {
                exp_sub_scale(s, mc - base, ilc);
                { bf16x8 pk[4]; pack_p(pk, s); SBAR_(); pv(o, pk, Vg, l32, hi); SBAR_(); }
#pragma unroll
                for (int kb = 0; kb < 2; ++kb)
#pragma unroll
                    for (int i = 0; i < 16; ++i) { float v = s[kb][i]; v += __shfl_xor(v, 8); v += __shfl_xor(v, 16); s[kb][i] = v; }
                if (l32_ < 8) {
#pragma unroll
                    for (int kb = 0; kb < 2; ++kb)
#pragma unroll
                        for (int a = 0; a < 4; ++a) {
                            const int js = 16 * j + 8 * kb + 2 * a + hi;
                            const float p3 = s[kb][4 * a + 3], mainv = 2.f * (s[kb][4 * a] + s[kb][4 * a + 1] + s[kb][4 * a + 2]) + p3;
                            impw[qi * 65 + js] += mainv;
                            impw[qi * 65 + js + 1] += p3;
                        }
                }
            }
        } else if (kind == 2) {
            const bool need = (j < 32) ? ((un_lo >> j) & 1u) : ((un_hi >> (j - 32)) & 1u);
            if (need) {
                const bool selbit = (j < 32) ? ((sel_lo >> j) & 1u) : ((sel_hi >> (j - 32)) & 1u);
                f32x16 s[2];
                if (j == qb) scores<1, true, false>(s, qx, qW, Kg, l32, hi, t - 64 * j - 4 * hi, 0);
                else scores<1, false, false>(s, qx, qW, Kg, l32, hi, 0, 0);
                online(s, o, m, l, selbit ? -slope2 * (float)(t - 64 * j - 4 * hi) : NEG_INF);
                bf16x8 pk[4]; pack_p(pk, s); SBAR_(); pv(o, pk, Vg, l32, hi);
            }
        } else if (kind == 4) {
            f32x16 s[2];
            if (j == qb) scores<1, true, false>(s, qx, qW, Kg, l32, hi, t - 64 * j - 4 * hi, 0);
            else if (j == qb - 8) scores<1, false, true>(s, qx, qW, Kg, l32, hi, 0, t - 512 - 64 * j - 4 * hi);
            else scores<1, false, false>(s, qx, qW, Kg, l32, hi, 0, 0);
            online(s, o, m, l, -slope2 * (float)(t - 64 * j - 4 * hi));
            bf16x8 pk[4]; pack_p(pk, s); SBAR_(); pv(o, pk, Vg, l32, hi);
        }
        __syncthreads();
        ++idx; par ^= 1;
        if (nxt < 0) break;
    }
    {
        const float lt = l + __shfl_xor(l, 32); const float sc = lt > 0.f ? gates[(size_t)row * 24 + head * 3 + 1] / lt : 0.f;
#pragma unroll
        for (int db = 0; db < 2; ++db)
#pragma unroll
            for (int i4 = 0; i4 < 2; ++i4) {
                const u32x4 wv = *(const LAS u32x4*)(stg + (db * 2 + i4) * 1024);
                o[db][8 * i4 + 0] = o[db][8 * i4 + 0] * sc + bflo(wv.x); o[db][8 * i4 + 1] = o[db][8 * i4 + 1] * sc + bfhi(wv.x);
                o[db][8 * i4 + 2] = o[db][8 * i4 + 2] * sc + bflo(wv.y); o[db][8 * i4 + 3] = o[db][8 * i4 + 3] * sc + bfhi(wv.y);
                o[db][8 * i4 + 4] = o[db][8 * i4 + 4] * sc + bflo(wv.z); o[db][8 * i4 + 5] = o[db][8 * i4 + 5] * sc + bfhi(wv.z);
                o[db][8 * i4 + 6] = o[db][8 * i4 + 6] * sc + bflo(wv.w); o[db][8 * i4 + 7] = o[db][8 * i4 + 7] * sc + bfhi(wv.w);
            }
    }
    float ss = 0.f;
#pragma unroll
    for (int db = 0; db < 2; ++db)
#pragma unroll
        for (int i = 0; i < 16; ++i) ss += o[db][i] * o[db][i];
    ss += __shfl_xor(ss, 8); ss += __shfl_xor(ss, 16); ss += __shfl_xor(ss, 32);
    if (lane < 8) SS[g * 64 + 8 * w + lane] = ss;
    bf16* op = mix + (size_t)row * DM + head * 64 + 4 * hi_;
#pragma unroll
    for (int db = 0; db < 2; ++db)
#pragma unroll
        for (int a = 0; a < 4; ++a) {
            u32x2 wv; wv.x = pk2(o[db][4 * a], o[db][4 * a + 1]); wv.y = pk2(o[db][4 * a + 2], o[db][4 * a + 3]);
            *(u32x2*)(op + db * 32 + 8 * a) = wv;
        }
    __syncthreads();
#undef ATT_ISSUE
#undef ATT_COMMIT
#undef ATT_REAL
}
__device__ __forceinline__ void attn_item(LAS unsigned char* lds, int b, int qb, const float* qng, const bf16* zq, const bf16* kvb, const bf16* kc, const bf16* vc, const float* gates, bf16* mix) {
#pragma nounroll
    for (int g = 0; g < 2; ++g) attn_pass(lds, b, qb, g, qng, zq, kvb, kc, vc, gates, mix);
    int tid_ = threadIdx.x; asm volatile("" : "+v"(tid_));
    const int tid = tid_, lane = tid & 63, w = __builtin_amdgcn_readfirstlane(tid >> 6), l32 = lane & 31, hi = lane >> 5, qi = lane & 7, hh = l32 >> 3;
    LAS float* SS = (LAS float*)(lds + OFF_RS);
    const int tq = 8 * w + qi, row = b * 4096 + qb * 64 + tq;
    const float rinv = __builtin_amdgcn_rsqf((SS[tq] + SS[64 + tq]) * (1.0f / 512.0f) + EPS);
#pragma nounroll
    for (int g = 0; g < 2; ++g) {
        bf16* op = mix + (size_t)row * DM + (g * 4 + hh) * 64 + 4 * hi;
#pragma unroll
        for (int db = 0; db < 2; ++db)
#pragma unroll
            for (int a = 0; a < 4; ++a) {
                u32x2* p = (u32x2*)(op + db * 32 + 8 * a);
                const u32x2 v = *p; u32x2 wv; wv.x = pk2(bflo(v.x) * rinv, bfhi(v.x) * rinv); wv.y = pk2(bflo(v.y) * rinv, bfhi(v.y) * rinv);
                *p = wv;
            }
    }
    __syncthreads();
}
}
#ifndef PHASES
#define PHASES 0x1ff
#endif

__device__ __forceinline__ void gmlp_item(LAS unsigned char* lds, int item, const bf16* zu, const bf16* zv, bf16* mix, const float* ln_g, const float* ln_b, const bf16* wsb, const float* gbs) {
    int tid_ = threadIdx.x; asm volatile("" : "+v"(tid_));
    const int tid = tid_, lane = tid & 63, w = __builtin_amdgcn_readfirstlane(tid >> 6);
    const int r0 = item * 128;
    constexpr int WROW = 272;
    LAS unsigned char* VT = lds;
    u32x2 uall[8][4];
    {
        const bf16* up = zu + (size_t)(r0 + 16 * w + (lane & 15)) * 512 + (lane >> 4) * 4;
#pragma unroll
        for (int g = 0; g < 8; ++g)
#pragma unroll
            for (int nb = 0; nb < 4; ++nb) uall[g][nb] = *(const u32x2*)(up + g * 64 + nb * 16);
    }
    {
        f32x4 g0 = *(const f32x4*)(ln_g + lane * 8), g1 = *(const f32x4*)(ln_g + lane * 8 + 4), b0 = *(const f32x4*)(ln_b + lane * 8), b1 = *(const f32x4*)(ln_b + lane * 8 + 4);
#pragma unroll 4
        for (int k = 0; k < 16; ++k) {
            const int tl = w * 16 + k;
            const u32x4 v = *(const u32x4*)(zv + (size_t)(r0 + tl) * 512 + lane * 8);
            float f[8] = {bflo(v.x), bfhi(v.x), bflo(v.y), bfhi(v.y), bflo(v.z), bfhi(v.z), bflo(v.w), bfhi(v.w)};
            float s = ((f[0] + f[1]) + (f[2] + f[3])) + ((f[4] + f[5]) + (f[6] + f[7]));
            float s2 = ((f[0] * f[0] + f[1] * f[1]) + (f[2] * f[2] + f[3] * f[3])) + ((f[4] * f[4] + f[5] * f[5]) + (f[6] * f[6] + f[7] * f[7]));
            s = wave_sum(s); s2 = wave_sum(s2);
            const float mean = s * (1.0f / 512.0f), var = fmaxf(s2 * (1.0f / 512.0f) - mean * mean, 0.f), rs = __builtin_amdgcn_rsqf(var + EPS);
#pragma unroll
            for (int e = 0; e < 8; ++e) {
                const float gg = e < 4 ? g0[e] : g1[e - 4], bb = e < 4 ? b0[e] : b1[e - 4];
                *(LAS unsigned short*)(VT + (lane * 8 + e) * WROW + (((tl >> 3) ^ (lane & 7)) << 4) + (tl & 7) * 2) = (unsigned short)f2bf((f[e] - mean) * rs * gg + bb);
            }
        }
    }
    __syncthreads();
    const int tl = 16 * w + (lane & 15), fq = lane >> 4;
    const int nks = (16 * w + 15) / 32 + 1;
    float ssq = 0.f;
    u32x2 oall[8][4];
    bf16x8 nb_fr[4]; float nbias;
#define GMLP_FETCH(g_) do { const bf16* wrow_ = wsb + ((size_t)((g_) * 128 + tl)) * 128 + fq * 8; \
        _Pragma("unroll") for (int ks = 0; ks < 4; ++ks) if (ks < nks) nb_fr[ks] = *(const bf16x8*)(wrow_ + ks * 32); \
        nbias = gbs[(g_) * 128 + tl]; } while (0)
    GMLP_FETCH(0);
#pragma unroll
    for (int g = 0; g < 8; ++g) {
        bf16x8 bfr[4]; u32x2 uu[4];
#pragma unroll
        for (int ks = 0; ks < 4; ++ks) bfr[ks] = nb_fr[ks];
#pragma unroll
        for (int nb = 0; nb < 4; ++nb) uu[nb] = uall[g][nb];
        const float bias = nbias;
        if (g < 7) GMLP_FETCH(g + 1);
        pg8::f32x4 c[4];
#pragma unroll
        for (int nb = 0; nb < 4; ++nb) c[nb] = (pg8::f32x4){0.f, 0.f, 0.f, 0.f};
#pragma unroll
        for (int ks = 0; ks < 4; ++ks) if (ks < nks) {
#pragma unroll
            for (int nb = 0; nb < 4; ++nb) {
                const bf16x8 afr = *(const LAS bf16x8*)(VT + (g * 64 + nb * 16 + (lane & 15)) * WROW + (((ks * 4 + fq) ^ ((nb * 2 + ((lane & 15) >> 3)) & 7)) << 4));
                c[nb] = __builtin_amdgcn_mfma_f32_16x16x32_bf16(afr, bfr[ks], c[nb], 0, 0, 0);
            }
        }
#pragma unroll
        for (int nb = 0; nb < 4; ++nb) {
            const int d0 = nb * 16 + fq * 4;
            const float v0 = bflo(uu[nb].x) * (c[nb][0] + bias), v1 = bfhi(uu[nb].x) * (c[nb][1] + bias), v2 = bflo(uu[nb].y) * (c[nb][2] + bias), v3 = bfhi(uu[nb].y) * (c[nb][3] + bias);
            ssq += (v0 * v0 + v1 * v1) + (v2 * v2 + v3 * v3);
            u32x2 o; o.x = pk2_hw(v0, v1); o.y = pk2_hw(v2, v3);
            oall[g][nb] = o;
        }
    }
#undef GMLP_FETCH
    ssq += __shfl_xor(ssq, 16); ssq += __shfl_xor(ssq, 32);
    const float rinv = __builtin_amdgcn_rsqf(ssq * (1.0f / 512.0f) + EPS);
#pragma unroll
    for (int g = 0; g < 8; ++g)
#pragma unroll
        for (int nb = 0; nb < 4; ++nb) {
            const u32x2 v = oall[g][nb]; u32x2 o; o.x = pk2_hw(bflo(v.x) * rinv, bfhi(v.x) * rinv); o.y = pk2_hw(bflo(v.y) * rinv, bfhi(v.y) * rinv);
            *(u32x2*)(mix + (size_t)(r0 + tl) * DM + 512 + g * 64 + nb * 16 + fq * 4) = o;
        }
    __syncthreads();
}

#define PHASE_PTRS() \
    unsigned char* ws = args.ws; asm volatile("" : "+s"(ws)); \
    int tidp_ = threadIdx.x; asm volatile("" : "+v"(tidp_)); \
    const int tid = tidp_, lane = tid & 63, w = __builtin_amdgcn_readfirstlane(tid >> 6), gw = bx * 8 + w, NGW = G * 8; (void)lane; (void)gw; (void)NGW; \
    const float* x = args.in[I_X]; (void)x; \
    float* b1p = (float*)(ws + WS_B1P); (void)b1p; \
    bf16* WinT = (bf16*)(ws + WS_WIN); bf16* WoT = (bf16*)(ws + WS_WO); bf16* W1T = (bf16*)(ws + WS_W1); bf16* W2T = (bf16*)(ws + WS_W2); (void)WinT; (void)WoT; (void)W1T; (void)W2T; \
    bf16* WgT = (bf16*)(ws + WS_WG); bf16* WpT = (bf16*)(ws + WS_WP); bf16* Wc1K = (bf16*)(ws + WS_WC1K); bf16* Wc1V = (bf16*)(ws + WS_WC1V); (void)WgT; (void)WpT; (void)Wc1K; (void)Wc1V; \
    float* rss1 = (float*)(ws + WS_RSS1); float* rss2 = (float*)(ws + WS_RSS2); (void)rss1; (void)rss2; \
    bf16* xb = (bf16*)(ws + WS_XB); bf16* pb = (bf16*)(ws + WS_PB); bf16* tp = (bf16*)(ws + WS_TP); bf16* h1 = (bf16*)(ws + WS_H1); (void)xb; (void)pb; (void)tp; (void)h1; \
    bf16* zq = (bf16*)(ws + WS_ZQ); bf16* zu = (bf16*)(ws + WS_ZU); bf16* zv = (bf16*)(ws + WS_ZV); bf16* mix = (bf16*)(ws + WS_MIX); (void)zq; (void)zu; (void)zv; (void)mix; \
    bf16* kvb = (bf16*)(ws + WS_KV); float* gates = (float*)(ws + WS_GATES); bf16* hdnK = (bf16*)(ws + WS_HDNK); bf16* hdnV = (bf16*)(ws + WS_HDNV); (void)kvb; (void)gates; (void)hdnK; (void)hdnV; \
    bf16* kc = (bf16*)(ws + WS_KC); bf16* vc = (bf16*)(ws + WS_VC); (void)kc; (void)vc; \
    bf16* wsb = (bf16*)(ws + WS_WSB); (void)wsb; float* hpart = (float*)(ws + WS_HDNK); (void)hpart;

__global__ void __launch_bounds__(512) fwd_megakernel(Args args) {
    extern __shared__ __attribute__((aligned(16))) unsigned char lds_raw[];
    LAS unsigned char* lds = (LAS unsigned char*)lds_raw;
    cg::grid_group grid = cg::this_grid();
    volatile LAS unsigned* MISC = (volatile LAS unsigned*)(lds + LDS_BYTES - 64);
    if (threadIdx.x < 16) MISC[threadIdx.x] = 0u;
    __syncthreads();
    if (blockIdx.x == 0) { unsigned* bw = (unsigned*)(args.ws + WS_BAR); for (int u = threadIdx.x; u < 4096; u += 512) __hip_atomic_store(bw + u, 0u, __ATOMIC_RELAXED, __HIP_MEMORY_SCOPE_AGENT); __threadfence(); }
    XcdBarrier xbar;
    const int G = gridDim.x, bx = blockIdx.x;

    #if (PHASES >> 0) & 1
    {
    PHASE_PTRS()
    if (bx < 32) {
        const int which = (bx >> 2) & 1, cgp = bx & 3, kq = bx >> 3, col = cgp * 64 + lane;
        const float* pos = args.in[which ? I_POSV : I_POSK]; const float* w1 = args.in[which ? I_CVW1 : I_CKW1]; const float* b1 = args.in[which ? I_CVB1 : I_CKB1];
        float acc8[16];
#pragma unroll
        for (int u = 0; u < 16; ++u) acc8[u] = 0.f;
        for (int k = kq * 512 + w * 64; k < kq * 512 + w * 64 + 64; k += 16) {
#pragma unroll
            for (int u = 0; u < 16; ++u) acc8[u] += pos[k + u] * w1[(size_t)(k + u) * 256 + col];
        }
        float acc = 0.f;
#pragma unroll
        for (int u = 0; u < 16; ++u) acc += acc8[u];
        LAS float* red = (LAS float*)lds;
        red[w * 64 + lane] = acc;
        __syncthreads();
        if (w == 0) { float s = kq == 0 ? b1[col] : 0.f; for (int k = 0; k < 8; ++k) s += red[k * 64 + lane]; b1p[kq * 512 + which * 256 + col] = s; }
        __syncthreads();
    }
    {
        LAS float* scr = (LAS float*)(lds + w * 16384);
        constexpr int N_IN_A = 16 * 40, N_IN_B = 16 * 32, N_IN_C = 16, N_O = 16 * 32, N_1 = 16 * 128, N_2 = 64 * 32, N_G = 16 * 32, N_P = 4 * 32, N_C = 32 * 8;
        constexpr int NITEMS = N_IN_A + N_IN_B + N_IN_C + N_O + N_1 + N_2 + N_G + N_P + 2 * N_C;
        for (int it = gw; it < NITEMS; it += NGW) {
            int r = it;
            if (r < N_IN_A) { tr_item(args.in[I_WIN], 2328, (r / 40) * 64, (r % 40) * 32, WinT, 1024, (r % 40) * 32, args.in[I_GMIX], scr, lane); continue; } r -= N_IN_A;
            if (r < N_IN_B) { tr_item(args.in[I_WIN], 2328, (r / 32) * 64, 1304 + (r % 32) * 32, WinT, 1024, 1280 + (r % 32) * 32, args.in[I_GMIX], scr, lane); continue; } r -= N_IN_B;
            if (r < N_IN_C) { tr_item(args.in[I_WIN], 2328, r * 64, 1280, WinT, 1024, 2304, args.in[I_GMIX], scr, lane); continue; } r -= N_IN_C;
            if (r < N_O) { const int k0 = (r / 32) * 64; tr_item(args.in[I_WOUT], 1024, k0, (r % 32) * 32, WoT, 1024, (r % 32) * 32, k0 < 512 ? args.in[I_OGN] : args.in[I_OGG] - 512, scr, lane); continue; } r -= N_O;
            if (r < N_1) { tr_item(args.in[I_WFF1], 4096, (r / 128) * 64, (r % 128) * 32, W1T, 1024, (r % 128) * 32, args.in[I_GFF], scr, lane); continue; } r -= N_1;
            if (r < N_2) { tr_item(args.in[I_WFF2], 1024, (r / 32) * 64, (r % 32) * 32, W2T, 4096, (r % 32) * 32, nullptr, scr, lane); continue; } r -= N_2;
            if (r < N_G) { tr_item(args.in[I_WPG], 1024, (r / 32) * 64, (r % 32) * 32, WgT, 1024, (r % 32) * 32, args.in[I_GPLE], scr, lane); continue; } r -= N_G;
            if (r < N_P) { tr_item(args.in[I_WPLE], 1024, (r / 32) * 64, (r % 32) * 32, WpT, 256, (r % 32) * 32, nullptr, scr, lane); continue; } r -= N_P;
            if (r < N_C) { tr_item(args.in[I_CKW1], 256, (r / 8) * 64, (r % 8) * 32, Wc1K, 2048, (r % 8) * 32, nullptr, scr, lane); continue; } r -= N_C;
            tr_item(args.in[I_CVW1], 256, (r / 8) * 64, (r % 8) * 32, Wc1V, 2048, (r % 8) * 32, nullptr, scr, lane);
        }
        for (int e = bx * 512 + tid; e < 8 * 128 * 128; e += G * 512) {
            const int tt = (e >> 7) & 127, sx = e & 127;
            wsb[e] = (bf16)f2bf(sx <= tt ? args.in[I_GWS][e] : 0.f);
        }
        for (int m0 = gw * 2; m0 < MROWS; m0 += NGW * 2) {
            f32x4 v[2][4]; f32x4 pv4[2]; float s[2];
#pragma unroll
            for (int r = 0; r < 2; ++r) {
                const f32x4* xr = (const f32x4*)(x + (size_t)(m0 + r) * DM) + lane;
#pragma unroll
                for (int j = 0; j < 4; ++j) v[r][j] = xr[64 * j];
                pv4[r] = *((const f32x4*)(args.in[I_P] + (size_t)(m0 + r) * DPLE) + lane);
            }
#pragma unroll
            for (int r = 0; r < 2; ++r) { s[r] = 0.f;
#pragma unroll
                for (int j = 0; j < 4; ++j) s[r] += (v[r][j][0] * v[r][j][0] + v[r][j][1] * v[r][j][1]) + (v[r][j][2] * v[r][j][2] + v[r][j][3] * v[r][j][3]); }
#pragma unroll
            for (int o = 1; o < 64; o <<= 1) { s[0] += __shfl_xor(s[0], o); s[1] += __shfl_xor(s[1], o); }
#pragma unroll
            for (int r = 0; r < 2; ++r) {
                const float rinv = __builtin_amdgcn_rsqf(s[r] * (1.0f / DM) + EPS);
                u32x2* o8 = (u32x2*)(xb + (size_t)(m0 + r) * DM) + lane;
#pragma unroll
                for (int j = 0; j < 4; ++j) { u32x2 o; o.x = pk2(v[r][j][0] * rinv, v[r][j][1] * rinv); o.y = pk2(v[r][j][2] * rinv, v[r][j][3] * rinv); o8[64 * j] = o; }
                u32x2 po; po.x = pk2(pv4[r][0], pv4[r][1]); po.y = pk2(pv4[r][2], pv4[r][3]);
                *((u32x2*)(pb + (size_t)(m0 + r) * DPLE) + lane) = po;
            }
        }
    }
        }
    grid.sync();
    xbar = xcd_barrier_post((unsigned*)(args.ws + WS_BAR), MISC + 8);

    #endif
#if (PHASES >> 1) & 1
    {
    PHASE_PTRS()
    {
        pg8::Gemm g{xb, WinT, MROWS, NINP, DM, DM, DM}; pg8::StaticOrder S; S.init(MROWS, NINP, G, bx);
        EpiRow<FIn> E{FIn{zq, kvb, zu, zv, gates}};
        pg8::gemm_phase<EpiRow<FIn>, pg8::StaticOrder, true, true>(lds, g, S, E);
    }
        }
    xcd_barrier(xbar);

    #endif
#if (PHASES >> 2) & 1
    {
    PHASE_PTRS()
    {
        const size_t nth = (size_t)G * 512, gt = (size_t)bx * 512 + tid;
        constexpr size_t NQR = 0, NKR = (size_t)MROWS * 2;
        for (size_t c = gt; c < (NQR + 2 * NKR) * 8; c += nth) {
            const size_t r = c >> 3; const int part = (int)(c & 7);
            bf16* p; const float* gn; float sc;
            if (r < NQR) { p = zq + r * 64; gn = args.in[I_QG]; sc = QSCALE; }
            else if (r < NQR + NKR) { p = kvb + 2 * KV_STRIDE + (r - NQR) * 64; gn = args.in[I_KSG]; sc = 1.f; }
            else { p = kvb + 4 * KV_STRIDE + (r - NQR - NKR) * 64; gn = args.in[I_KWG]; sc = 1.f; }
            const u32x4 v = *(const u32x4*)(p + part * 8);
            float f[8] = {bflo(v.x), bfhi(v.x), bflo(v.y), bfhi(v.y), bflo(v.z), bfhi(v.z), bflo(v.w), bfhi(v.w)};
            float s = 0.f;
#pragma unroll
            for (int e = 0; e < 8; ++e) s += f[e] * f[e];
            s += __shfl_xor(s, 1); s += __shfl_xor(s, 2); s += __shfl_xor(s, 4);
            const float rinv = __builtin_amdgcn_rsqf(s * (1.0f / 64.0f) + EPS) * sc;
#pragma unroll
            for (int e = 0; e < 8; ++e) f[e] = f[e] * rinv * gn[part * 8 + e];
            u32x4 o; o.x = pk2(f[0], f[1]); o.y = pk2(f[2], f[3]); o.z = pk2(f[4], f[5]); o.w = pk2(f[6], f[7]);
            *(u32x4*)(p + part * 8) = o;
        }
    }
    {
        const int u = bx < 128 ? bx : -1, which = (u >> 6) & 1, pm = (u >> 2) & 15, sl = u & 3;
        pg8::Gemm g{kvb + (which ? KV_STRIDE : 0) + sl * 512, (which ? Wc1V : Wc1K) + sl * 512, 4096, 256, 512, 1024, 2048}; OneUnit S{u >= 0 ? pm : -1};
        EpiRow<FPart> E{FPart{hpart + ((size_t)which * 4 + sl) * 4096 * 256}};
        pg8::gemm_phase<EpiRow<FPart>, OneUnit, true, true>(lds, g, S, E);
    }
    {
        pg8::Gemm g{pb, WpT, MROWS, DM, DPLE, DPLE, DPLE}; TpDeal S{bx, G};
        EpiRow<FPlain> E{FPlain{tp, DM}};
        pg8::gemm_phase<EpiRow<FPlain>, TpDeal, true, true>(lds, g, S, E);
    }
    {
        for (int it = bx; it < 256; it += G) gmlp_item(lds, it, zu, zv, mix, args.in[I_LNG], args.in[I_LNB], wsb, args.in[I_GBS]);
    }
        }
    xcd_barrier(xbar);

    #endif
#if (PHASES >> 3) & 1
    {
    PHASE_PTRS()
    {
    LAS float* hw = (LAS float*)(lds + w * 2048);
    for (int pr = gw; pr < 2 * 2048; pr += NGW) {
        const int p_ = __builtin_amdgcn_readfirstlane(pr), which = p_ >> 11, riA = p_ & 2047, riB = riA + 2048;
        const float* w2 = args.in[which ? I_CVW2 : I_CKW2];
        f32x4 hb = *(const f32x4*)(b1p + which * 256 + lane * 4);
#pragma unroll
        for (int kq = 1; kq < 4; ++kq) hb += *(const f32x4*)(b1p + kq * 512 + which * 256 + lane * 4);
        const float* hpA = hpart + ((size_t)which * 4 * 4096 + riA) * 256 + lane * 4;
        const float* hpB = hpart + ((size_t)which * 4 * 4096 + riB) * 256 + lane * 4;
        f32x4 hA = hb, hB = hb;
#pragma unroll
        for (int sl = 0; sl < 4; ++sl) { hA += *(const f32x4*)(hpA + (size_t)sl * 4096 * 256); hB += *(const f32x4*)(hpB + (size_t)sl * 4096 * 256); }
#pragma unroll
        for (int e = 0; e < 4; ++e) { hA[e] = gelu_tanh(hA[e]); hB[e] = gelu_tanh(hB[e]); }
        *(LAS f32x4*)(hw + lane * 4) = hA; *(LAS f32x4*)(hw + 256 + lane * 4) = hB;
        const float bias2 = args.in[which ? I_CVB2 : I_CKB2][lane];
        float accA = bias2, accB = bias2;
#pragma unroll 8
        for (int k2 = 0; k2 < 256; k2 += 4) { const f32x4 ha = *(const LAS f32x4*)(hw + k2), hc = *(const LAS f32x4*)(hw + 256 + k2);
            const float w0 = w2[k2 * 64 + lane], w1 = w2[(k2 + 1) * 64 + lane], w2v = w2[(k2 + 2) * 64 + lane], w3 = w2[(k2 + 3) * 64 + lane];
            accA += ha[0] * w0 + ha[1] * w1 + ha[2] * w2v + ha[3] * w3; accB += hc[0] * w0 + hc[1] * w1 + hc[2] * w2v + hc[3] * w3; }
#pragma unroll
        for (int hh2 = 0; hh2 < 2; ++hh2) {
            const int ri = hh2 ? riB : riA; float acc = hh2 ? accB : accA;
            bf16* op = which ? vc + (size_t)(ri >> 8) * 16384 + (size_t)((ri & 255) >> 6) * 4096 + (size_t)lane * 64 + (ri & 63) : kc + (size_t)ri * 64 + lane;
            if ((ri & 255) == 255) { *op = 0; continue; }
            if (!which) { const float ssum = wave_sum(acc * acc); acc *= __builtin_amdgcn_rsqf(ssum * (1.0f / 64.0f) + EPS) * args.in[I_KCG][lane]; }
            *op = (bf16)f2bf(acc);
        }
    }
    }
        }
    xcd_barrier(xbar);

    #endif
#if (PHASES >> 4) & 1
    {
    PHASE_PTRS()
    for (int pi = bx; pi < 256; pi += G) {
        const int b = pi >> 5, qa = pi & 31;
#pragma nounroll
        for (int hh = 0; hh < 2; ++hh) att::attn_item(lds, b, hh ? qa : 63 - qa, args.in[I_QG], zq, kvb, kc, vc, gates, mix);
    }
        }
    xcd_barrier(xbar);

    #endif
#if (PHASES >> 5) & 1
    {
    PHASE_PTRS()
    {
        pg8::Gemm g{mix, WoT, MROWS, DM, DM, DM, DM}; pg8::StaticOrder S; S.init(MROWS, DM, G, bx);
        EpiRowP<FResA> E{FResA{x, xb, rss1}};
        pg8::gemm_phase<EpiRowP<FResA>, pg8::StaticOrder, true, true>(lds, g, S, E);
    }
        }
    xcd_barrier(xbar);
    #endif
#if (PHASES >> 6) & 1
    {
    PHASE_PTRS()
    {
        pg8::Gemm g{xb, W1T, MROWS, FF, DM, DM, DM}; pg8::StaticOrder S; S.init(MROWS, FF, G, bx);
        EpiRowP<FFF1> E{FFF1{h1, rss1}};
        pg8::gemm_phase<EpiRowP<FFF1>, pg8::StaticOrder, true, true>(lds, g, S, E);
    }
        }
    xcd_barrier(xbar);
    #endif
#if (PHASES >> 7) & 1
    {
    PHASE_PTRS()
    {
        pg8::Gemm g{h1, W2T, MROWS, DM, FF, FF, FF}; pg8::StaticOrder S; S.init(MROWS, DM, G, bx);
        EpiRowP<FResB> E{FResB{args.out, xb, rss2}};
        pg8::gemm_phase<EpiRowP<FResB>, pg8::StaticOrder, true, true>(lds, g, S, E);
    }
        }
    xcd_barrier(xbar);
    #endif
#if (PHASES >> 8) & 1
    {
    PHASE_PTRS()
    {
        pg8::Gemm g{xb, WgT, MROWS, DM, DM, DM, DM}; pg8::StaticOrder S; S.init(MROWS, DM, G, bx);
        EpiRow<FGate> E{FGate{args.out, tp, rss2}};
        pg8::gemm_phase<EpiRow<FGate>, pg8::StaticOrder, true, true>(lds, g, S, E);
    }
    }
    #endif
}

extern "C" void kernel_launch(void* const* d_in, const int* in_sizes, int n_in, void* d_out, int out_size, void* d_ws, size_t ws_size, hipStream_t stream) {
    static int grid = 0;
    if (!grid) {
        int dev = 0, cus = 0, per_cu = 0;
        hipGetDevice(&dev);
        hipDeviceGetAttribute(&cus, hipDeviceAttributeMultiprocessorCount, dev);
        hipFuncSetAttribute((const void*)fwd_megakernel, hipFuncAttributeMaxDynamicSharedMemorySize, LDS_BYTES);
        hipOccupancyMaxActiveBlocksPerMultiprocessor(&per_cu, (const void*)fwd_megakernel, 512, LDS_BYTES);
        if (per_cu < 1) per_cu = 1;
        grid = cus * per_cu;
        if (n_in != 31 || ws_size < WS_BIG + 256 * MiB) fprintf(stderr, "kernel_launch: unexpected n_in %d / ws %zu\n", n_in, ws_size);
    }
    Args a{};
    for (int i = 0; i < 31; ++i) a.in[i] = (const float*)d_in[i];
    a.out = (float*)d_out; a.ws = (unsigned char*)d_ws;
    void* args[] = {&a};
    hipError_t e = hipLaunchCooperativeKernel((void*)fwd_megakernel, dim3(grid), dim3(512), args, LDS_BYTES, stream);
    if (e != hipSuccess) fprintf(stderr, "cooperative launch failed: %s (grid %d)\n", hipGetErrorString(e), grid);
}
```

```cpp
#include <hip/hip_runtime.h>
#include <hip/hip_cooperative_groups.h>
#include <cstdio>
#include <cstdint>
namespace cg = cooperative_groups;
namespace pg8 {
#define PG8_LAS __attribute__((address_space(3)))
typedef unsigned short bf16_t;
typedef short bf16x8 __attribute__((ext_vector_type(8)));
typedef float f32x4 __attribute__((ext_vector_type(4)));
typedef unsigned u32x4 __attribute__((ext_vector_type(4)));
constexpr int BM = 256, BK = 64, HALF = 128, HTB = HALF * BK * 2  , STAGE_BYTES = 8 * HTB, NXCD = 8, WGM = 8;

__host__ __device__ __forceinline__ int lds_byte(int r, int c) { const int st = (r >> 4) * 2 + (c >> 5), rr = r & 15, cc = c & 31, ob = rr * 64 + cc * 2; return st * 1024 + (ob ^ (((ob >> 9) & 1) << 5)); }
__host__ __device__ __forceinline__ void stage_rc(int b, int& R, int& C) { const int st = b / 1024, sb = b % 1024, swz = sb ^ (((sb >> 9) & 1) << 5); R = (st >> 1) * 16 + swz / 64; C = (st & 1) * 32 + (swz % 64) / 2; }
__host__ __device__ __forceinline__ int perm32(int rho) { const int n = rho >> 4, i = rho & 15; return 8 * (i >> 2) + 4 * n + (i & 3); }

struct Unit { int pm, pn; };
struct Gemm { const bf16_t* A; const bf16_t* Bt; int M, N, K, lda, ldb; };

struct StaticOrder {
    int nM, nN, nwg, G, c;
    __host__ __device__ void init(int M, int N, int G_, int c_) { nM = M / BM; nN = N / BM; nwg = nM * nN; G = G_; c = c_; }
    __host__ __device__ bool next(int i, Unit& u) const {
        const long L = (long)i * G + c; if (L >= nwg) return false;
        int wgid = (int)L; { const int q = nwg / NXCD, r = nwg % NXCD, xcd = wgid % NXCD, off = wgid / NXCD; wgid = (xcd < r ? xcd * (q + 1) : r * (q + 1) + (xcd - r) * q) + off; }
        const int nig = WGM * nN, gid = wgid / nig, fm = gid * WGM, gsz = (nM - fm) < WGM ? (nM - fm) : WGM;
        u.pm = fm + ((wgid % nig) % gsz); u.pn = (wgid % nig) / gsz; return true;
    }
    __device__ __forceinline__ void a_ready(const Unit&) const {}
    __device__ __forceinline__ void done(const Unit&) const {}
};

__device__ __forceinline__ unsigned cvt_pk_bf16(float lo, float hi) { unsigned r; asm volatile("v_cvt_pk_bf16_f32 %0, %1, %2" : "=v"(r) : "v"(lo), "v"(hi)); return r; }
template <class Epi, class Sched, bool ALIGN_EPI = false, bool SP2 = false>
__device__ __forceinline__ void gemm_phase(PG8_LAS unsigned char* lds, const Gemm g, const Sched& S, const Epi& E) {
    int tid_ = threadIdx.x; asm volatile("" : "+v"(tid_));
    const int tid = tid_, wid = __builtin_amdgcn_readfirstlane(tid >> 6), lane = tid & 63, wr = wid >> 2, wc = wid & 3, fr = lane & 15, fq = lane >> 4;
    const int K = g.K, nt = K / BK;
    unsigned voffA[2], voffB[2];
#pragma unroll
    for (int i = 0; i < 2; ++i) { int R, C; stage_rc(tid * 16 + i * 8192, R, C); const int Rb = Epi::PERM ? ((R & ~31) + perm32(R & 31)) : R;
        voffA[i] = (unsigned)(R * g.lda + C) * 2u; voffB[i] = (unsigned)(Rb * g.ldb + C) * 2u; }
    const size_t kstep = (size_t)(BK * 2);
    const size_t hstepA = (size_t)HALF * g.lda * 2, hstepB = (size_t)HALF * g.ldb * 2;
    const size_t tstepA = 2 * hstepA, tstepB = 2 * hstepB;
    const unsigned ldsw = (unsigned)wid * 1024u;
    const int aoff = lds_byte(wr * 64 + fr, fq * 8), boff = lds_byte(wc * 32 + fr, fq * 8);
#define PG8_SA(b, h) (((b) * 2 + (h)) * HTB)
#define PG8_SB(b, h) ((4 + (b) * 2 + (h)) * HTB)
#define PG8_STAGE(bufoff, gbase, voff) do { _Pragma("unroll") for (int _i = 0; _i < 2; ++_i) \
        __builtin_amdgcn_global_load_lds((const unsigned*)((const char*)(gbase) + (voff)[_i]), (PG8_LAS unsigned*)(lds + (bufoff) + ldsw + _i * 8192), 16, 0, 0); } while (0)
#define PG8_LDA(dst, b, h) do { _Pragma("unroll") for (int m = 0; m < 4; ++m) _Pragma("unroll") for (int k = 0; k < 2; ++k) dst[m][k] = *(const PG8_LAS bf16x8*)(lds + PG8_SA(b, h) + aoff + m * 2048 + k * 1024); } while (0)
#define PG8_LDB(dst, b, h) do { _Pragma("unroll") for (int n = 0; n < 2; ++n) _Pragma("unroll") for (int k = 0; k < 2; ++k) dst[n][k] = *(const PG8_LAS bf16x8*)(lds + PG8_SB(b, h) + boff + n * 2048 + k * 1024); } while (0)
#define PG8_MMA(ai, bj, At, Bt) do { __builtin_amdgcn_s_setprio(1); _Pragma("unroll") for (int m = 0; m < 4; ++m) _Pragma("unroll") for (int n = 0; n < 2; ++n) _Pragma("unroll") for (int k = 0; k < 2; ++k) \
        acc[ai][bj][m][n] = __builtin_amdgcn_mfma_f32_16x16x32_bf16(Bt[n][k], At[m][k], acc[ai][bj][m][n], 0, 0, 0); __builtin_amdgcn_s_setprio(0); } while (0)
#define PG8_WAIT_V(n) asm volatile("s_waitcnt vmcnt(" #n ")" ::: "memory")
#define PG8_WAIT_L(n) asm volatile("s_waitcnt lgkmcnt(" #n ")" ::: "memory")
#define PG8_BAR __builtin_amdgcn_s_barrier()
#define PG8_SCHED __builtin_amdgcn_sched_barrier(0)
    Unit cur, nxt; int ui = 0;
    if (!S.next(0, cur)) return;
    f32x4 acc[2][2][4][2];
#pragma unroll
    for (int a = 0; a < 2; ++a)
#pragma unroll
        for (int b = 0; b < 2; ++b)
#pragma unroll
            for (int m = 0; m < 4; ++m)
#pragma unroll
                for (int n = 0; n < 2; ++n) acc[a][b][m][n] = (f32x4){0.f, 0.f, 0.f, 0.f};
    bf16x8 At[4][2], B0[2][2], B1[2][2];
    const char* cA = (const char*)g.A + (size_t)cur.pm * tstepA; const char* cB = (const char*)g.Bt + (size_t)cur.pn * tstepB;
    S.a_ready(cur);
    if constexpr (SP2) {
        PG8_STAGE(PG8_SB(0, 0), cB, voffB); PG8_STAGE(PG8_SB(0, 1), cB + hstepB, voffB); PG8_STAGE(PG8_SA(0, 0), cA, voffA); PG8_STAGE(PG8_SA(0, 1), cA + hstepA, voffA);
        if (wr == 1) PG8_BAR;
        PG8_WAIT_V(2); PG8_BAR;
        PG8_STAGE(PG8_SB(1, 0), cB + kstep, voffB); PG8_STAGE(PG8_SA(1, 0), cA + kstep, voffA); PG8_STAGE(PG8_SB(1, 1), cB + hstepB + kstep, voffB);
        PG8_WAIT_V(6); PG8_BAR;
    } else {
        PG8_STAGE(PG8_SB(0, 0), cB, voffB); PG8_STAGE(PG8_SA(0, 0), cA, voffA); PG8_STAGE(PG8_SB(0, 1), cB + hstepB, voffB); PG8_STAGE(PG8_SA(0, 1), cA + hstepA, voffA);
        if (wr == 1) PG8_BAR;
        PG8_WAIT_V(4); PG8_BAR;
        PG8_STAGE(PG8_SB(1, 0), cB + kstep, voffB); PG8_STAGE(PG8_SA(1, 0), cA + kstep, voffA); PG8_STAGE(PG8_SB(1, 1), cB + hstepB + kstep, voffB);
        PG8_WAIT_V(6); PG8_BAR;
    }
    for (;;) {
        const bool has_next = S.next(ui + 1, nxt);
        const char* nA = has_next ? (const char*)g.A + (size_t)nxt.pm * tstepA : cA; const char* nB = has_next ? (const char*)g.Bt + (size_t)nxt.pn * tstepB : cB;
        for (int t = 0; t < nt; t += 2) {
            const bool last = (t == nt - 2);
            const char* a1 = cA + (size_t)(t + 1) * kstep;
            const char* a2 = last ? nA : cA + (size_t)(t + 2) * kstep; const char* b2 = last ? nB : cB + (size_t)(t + 2) * kstep;
            const char* a3 = a2 + kstep; const char* b3 = b2 + kstep;
            if (last && has_next) S.a_ready(nxt);
            if constexpr (SP2) {
            PG8_LDB(B0, 0, 0); PG8_LDB(B1, 0, 1); PG8_SCHED; PG8_LDA(At, 0, 0); PG8_STAGE(PG8_SA(1, 1), a1 + hstepA, voffA);
            PG8_WAIT_V(8); PG8_WAIT_L(0); PG8_BAR; PG8_MMA(0, 0, At, B0); PG8_MMA(0, 1, At, B1); PG8_BAR; PG8_SCHED;
            PG8_LDA(At, 0, 1); PG8_STAGE(PG8_SB(0, 0), b2, voffB); PG8_STAGE(PG8_SB(0, 1), b2 + hstepB, voffB); PG8_STAGE(PG8_SA(0, 0), a2, voffA);
            PG8_WAIT_V(8); PG8_WAIT_L(0); PG8_BAR; PG8_MMA(1, 0, At, B0); PG8_MMA(1, 1, At, B1); PG8_BAR; PG8_SCHED;
            PG8_LDB(B0, 1, 0); PG8_LDB(B1, 1, 1); PG8_SCHED; PG8_LDA(At, 1, 0); PG8_STAGE(PG8_SA(0, 1), a2 + hstepA, voffA);
            PG8_WAIT_V(8); PG8_WAIT_L(0); PG8_BAR; PG8_MMA(0, 0, At, B0); PG8_MMA(0, 1, At, B1); PG8_BAR; PG8_SCHED;
            PG8_LDA(At, 1, 1); PG8_STAGE(PG8_SB(1, 0), b3, voffB); PG8_STAGE(PG8_SB(1, 1), b3 + hstepB, voffB); PG8_STAGE(PG8_SA(1, 0), a3, voffA);
            PG8_WAIT_V(8); PG8_WAIT_L(0); PG8_BAR; PG8_MMA(1, 0, At, B0); PG8_MMA(1, 1, At, B1); PG8_BAR; PG8_SCHED;
            } else {
            PG8_LDB(B0, 0, 0); PG8_SCHED; PG8_LDA(At, 0, 0); PG8_STAGE(PG8_SA(1, 1), a1 + hstepA, voffA);
            PG8_WAIT_L(8); PG8_BAR; PG8_WAIT_L(0); PG8_MMA(0, 0, At, B0); PG8_BAR; PG8_SCHED;
            PG8_LDB(B1, 0, 1); PG8_STAGE(PG8_SB(0, 0), b2, voffB);
            PG8_BAR; PG8_WAIT_L(0); PG8_MMA(0, 1, At, B1); PG8_BAR;
            PG8_LDA(At, 0, 1); PG8_STAGE(PG8_SA(0, 0), a2, voffA);
            PG8_BAR; PG8_WAIT_L(0); PG8_MMA(1, 0, At, B0); PG8_BAR; PG8_SCHED;
            PG8_STAGE(PG8_SB(0, 1), b2 + hstepB, voffB);
            PG8_WAIT_V(6); PG8_BAR; PG8_MMA(1, 1, At, B1); PG8_BAR;
            PG8_LDB(B0, 1, 0); PG8_SCHED; PG8_LDA(At, 1, 0); PG8_STAGE(PG8_SA(0, 1), a2 + hstepA, voffA);
            PG8_WAIT_L(8); PG8_BAR; PG8_WAIT_L(0); PG8_MMA(0, 0, At, B0); PG8_BAR; PG8_SCHED;
            PG8_LDB(B1, 1, 1); PG8_STAGE(PG8_SB(1, 0), b3, voffB);
            PG8_BAR; PG8_WAIT_L(0); PG8_MMA(0, 1, At, B1); PG8_BAR;
            PG8_LDA(At, 1, 1); PG8_STAGE(PG8_SA(1, 0), a3, voffA);
            PG8_BAR; PG8_WAIT_L(0); PG8_MMA(1, 0, At, B0); PG8_BAR; PG8_SCHED;
            PG8_STAGE(PG8_SB(1, 1), b3 + hstepB, voffB);
            PG8_WAIT_V(6); PG8_BAR; PG8_MMA(1, 1, At, B1); PG8_BAR;
            }
        }
        if constexpr (ALIGN_EPI) { if (wr == 0) PG8_BAR; }
        if constexpr (!Epi::AFTER_DRAIN) { E(acc, cur, wr, wc, fr, fq); S.done(cur); }
        if (!has_next) break;
#pragma unroll
        for (int a = 0; a < 2; ++a)
#pragma unroll
            for (int b = 0; b < 2; ++b)
#pragma unroll
                for (int m = 0; m < 4; ++m)
#pragma unroll
                    for (int n = 0; n < 2; ++n) acc[a][b][m][n] = (f32x4){0.f, 0.f, 0.f, 0.f};
        cur = nxt; cA = nA; cB = nB; ++ui;
        if constexpr (ALIGN_EPI) { if (wr == 1) PG8_BAR; }
    }
    PG8_WAIT_V(0);
    if constexpr (!ALIGN_EPI) { if (wr == 0) PG8_BAR; }
    PG8_BAR;
    if constexpr (Epi::AFTER_DRAIN) { E.fused(acc, cur, wr, wc, fr, fq, lds, wid, lane); S.done(cur); }
#undef PG8_SA
#undef PG8_SB
#undef PG8_STAGE
#undef PG8_LDA
#undef PG8_LDB
#undef PG8_MMA
#undef PG8_WAIT_V
#undef PG8_WAIT_L
#undef PG8_BAR
#undef PG8_SCHED
}
}

#define LAS __attribute__((address_space(3)))
typedef unsigned short bf16;
typedef unsigned u32x4 __attribute__((ext_vector_type(4)));
typedef unsigned u32x2 __attribute__((ext_vector_type(2)));
typedef float f32x4 __attribute__((ext_vector_type(4)));
typedef float f32x16 __attribute__((ext_vector_type(16)));
typedef short bf16x8 __attribute__((ext_vector_type(8)));

constexpr int NB = 8, NT = 4096, DM = 1024, MROWS = NB * NT, FF = 4096, DPLE = 256, NINP = 2560;
constexpr float EPS = 1e-6f;
constexpr float LOG2E = 1.4426950408889634f;
constexpr float QSCALE = 0.125f * LOG2E;
constexpr size_t MiB = (size_t)1 << 20;
constexpr size_t WS_BAR = 512 * 1024, WS_WSB = 640 * 1024;
constexpr size_t WS_BAR_ = 0;
constexpr size_t WS_B1P = 0, WS_WIN = 1 * MiB, WS_WO = 6 * MiB, WS_W1 = 8 * MiB, WS_W2 = 16 * MiB, WS_WG = 24 * MiB, WS_WP = 26 * MiB,
                 WS_WC1K = 27 * MiB, WS_WC1V = 28 * MiB, WS_RSS1 = 29 * MiB, WS_RSS2 = 31 * MiB, WS_XB = 34 * MiB, WS_PB = 98 * MiB,
                 WS_TP = 114 * MiB, WS_BIG = 178 * MiB;
constexpr size_t WS_H1 = WS_BIG, WS_ZQ = WS_BIG, WS_ZU = WS_BIG + 32 * MiB, WS_ZV = WS_BIG + 64 * MiB, WS_MIX = WS_BIG + 96 * MiB,
                 WS_KV = WS_BIG + 160 * MiB, KV_STRIDE_B = 9 * MiB, WS_GATES = WS_BIG + 214 * MiB, WS_HDNK = WS_BIG + 217 * MiB,
                 WS_HDNV = WS_BIG + 219 * MiB, WS_KC = WS_BIG + 250 * MiB, WS_VC = WS_BIG + 251 * MiB;
constexpr size_t KV_STRIDE = KV_STRIDE_B / 2;
constexpr int LDS_BYTES = 153600;

struct Args { const float* in[31]; float* out; unsigned char* ws; };
enum { I_X = 0, I_P, I_GMIX, I_WIN, I_QG, I_KCG, I_KSG, I_KWG, I_POSK, I_POSV, I_CKW1, I_CKB1, I_CKW2, I_CKB2, I_CVW1, I_CVB1, I_CVW2, I_CVB2,
       I_LNG, I_LNB, I_GWS, I_GBS, I_OGN, I_OGG, I_WOUT, I_GFF, I_WFF1, I_WFF2, I_GPLE, I_WPG, I_WPLE };

__device__ __forceinline__ unsigned f2bf(float f) { unsigned u = __builtin_bit_cast(unsigned, f); return (u + 0x7fffu + ((u >> 16) & 1u)) >> 16; }
typedef __bf16 bf16x2_t __attribute__((ext_vector_type(2))); typedef float f32x2_t __attribute__((ext_vector_type(2)));
__device__ __forceinline__ unsigned pk2(float lo, float hi) { return f2bf(lo) | (f2bf(hi) << 16); }
__device__ __forceinline__ unsigned pk2_hw(float lo, float hi) { f32x2_t v = {lo, hi}; bf16x2_t b = __builtin_convertvector(v, bf16x2_t); return __builtin_bit_cast(unsigned, b); }
__device__ __forceinline__ float bflo(unsigned u) { return __builtin_bit_cast(float, u << 16); }
__device__ __forceinline__ float bfhi(unsigned u) { return __builtin_bit_cast(float, u & 0xffff0000u); }
__device__ __forceinline__ float wave_sum(float v) {
    v += __builtin_bit_cast(float, __builtin_amdgcn_update_dpp(0, __builtin_bit_cast(int, v), 0xB1, 0xf, 0xf, false));
    v += __builtin_bit_cast(float, __builtin_amdgcn_update_dpp(0, __builtin_bit_cast(int, v), 0x4E, 0xf, 0xf, false));
    v += __builtin_bit_cast(float, __builtin_amdgcn_update_dpp(0, __builtin_bit_cast(int, v), 0x141, 0xf, 0xf, false));
    v += __builtin_bit_cast(float, __builtin_amdgcn_update_dpp(0, __builtin_bit_cast(int, v), 0x140, 0xf, 0xf, false));
    v += __builtin_bit_cast(float, __builtin_amdgcn_update_dpp(0, __builtin_bit_cast(int, v), 0x142, 0xa, 0xf, false));
    v += __builtin_bit_cast(float, __builtin_amdgcn_update_dpp(0, __builtin_bit_cast(int, v), 0x143, 0xc, 0xf, false));
    return __builtin_bit_cast(float, __builtin_amdgcn_readlane(__builtin_bit_cast(int, v), 63));
}
__device__ __forceinline__ float gelu_tanh(float x) {
    const float u = x + 0.044715f * x * x * x;
    const float e = __builtin_amdgcn_exp2f(-2.3022082f * u);
    return x * __builtin_amdgcn_rcpf(1.0f + e);
}
__device__ __forceinline__ float sigmoidf_(float x) { return __builtin_amdgcn_rcpf(1.0f + __builtin_amdgcn_exp2f(-LOG2E * x)); }
__device__ __forceinline__ u32x4 pack8(f32x4 a, f32x4 b) { u32x4 w; w.x = pk2(a[0], a[1]); w.y = pk2(a[2], a[3]); w.z = pk2(b[0], b[1]); w.w = pk2(b[2], b[3]); return w; }
__device__ __forceinline__ u32x4 pack8_hw(f32x4 a, f32x4 b) { u32x4 w; w.x = pg8::cvt_pk_bf16(a[0], a[1]); w.y = pg8::cvt_pk_bf16(a[2], a[3]); w.z = pg8::cvt_pk_bf16(b[0], b[1]); w.w = pg8::cvt_pk_bf16(b[2], b[3]); return w; }

template <class F> struct EpiRow {
    static constexpr bool PERM = true, AFTER_DRAIN = false;
    F f;
    __device__ __forceinline__ void operator()(const pg8::f32x4 (&acc)[2][2][4][2], const pg8::Unit& u, int wr, int wc, int fr, int fq) const {
        const int c0 = u.pn * 256 + wc * 32 + 8 * fq;
#pragma unroll
        for (int ai = 0; ai < 2; ++ai)
#pragma unroll
            for (int m = 0; m < 4; ++m) {
                const int row = u.pm * 256 + ai * 128 + wr * 64 + m * 16 + fr;
                f(row, c0, u.pn * 4 + wc, acc[ai][0][m][0], acc[ai][0][m][1], acc[ai][1][m][0], acc[ai][1][m][1]);
            }
    }
};

template <class F> struct EpiRowP {
    static constexpr bool PERM = true, AFTER_DRAIN = false;
    F f;
    __device__ __forceinline__ void operator()(const pg8::f32x4 (&acc)[2][2][4][2], const pg8::Unit& u, int wr, int wc, int fr, int fq) const {
        const int c0 = u.pn * 256 + wc * 32 + 8 * fq, rbase = u.pm * 256 + wr * 64 + fr;
        typename F::Pre nx = f.pre(rbase, c0);
#pragma unroll
        for (int idx = 0; idx < 8; ++idx) {
            const int ai = idx >> 2, m = idx & 3, row = rbase + ai * 128 + m * 16;
            const typename F::Pre cur = nx;
            if (idx < 7) nx = f.pre(rbase + ((idx + 1) >> 2) * 128 + ((idx + 1) & 3) * 16, c0);
            f(row, c0, u.pn * 4 + wc, acc[ai][0][m][0], acc[ai][0][m][1], acc[ai][1][m][0], acc[ai][1][m][1], cur);
        }
    }
};
struct Pre4 { f32x4 v[4]; };
__device__ __forceinline__ float rinv_from(const Pre4& p) {
    const float s = ((p.v[0][0] + p.v[0][1]) + (p.v[0][2] + p.v[0][3])) + ((p.v[1][0] + p.v[1][1]) + (p.v[1][2] + p.v[1][3])) + ((p.v[2][0] + p.v[2][1]) + (p.v[2][2] + p.v[2][3])) + ((p.v[3][0] + p.v[3][1]) + (p.v[3][2] + p.v[3][3]));
    return __builtin_amdgcn_rsqf(s * (1.0f / DM) + EPS);
}
struct FIn {
    bf16* zq; bf16* kv; bf16* zu; bf16* zv; float* gates;
    __device__ __forceinline__ void one(int row, int col, f32x4 v0, f32x4 v1) const {
        if (col < 512) { *(u32x4*)(zq + (size_t)row * 512 + col) = pack8_hw(v0, v1); }
        else if (col < 1280) { const int cc = col - 512, seg = cc >> 7, w = cc & 127, g = w >> 6, d = w & 63, b = row >> 12, t = row & 4095;
            if (seg == 3 || seg == 5) {
                bf16* vt = kv + (size_t)seg * KV_STRIDE + ((size_t)(b * 2 + g) * 4096 + (t & ~63)) * 64 + (size_t)d * 64 + (t & 63);
                const u32x4 pk = pack8_hw(v0, v1);
                vt[0 * 64] = (bf16)(pk.x & 0xffff); vt[1 * 64] = (bf16)(pk.x >> 16); vt[2 * 64] = (bf16)(pk.y & 0xffff); vt[3 * 64] = (bf16)(pk.y >> 16);
                vt[4 * 64] = (bf16)(pk.z & 0xffff); vt[5 * 64] = (bf16)(pk.z >> 16); vt[6 * 64] = (bf16)(pk.w & 0xffff); vt[7 * 64] = (bf16)(pk.w >> 16);
            } else
            *(u32x4*)(kv + (size_t)seg * KV_STRIDE + (((size_t)(b * 2 + g) * 4096 + t) * 64 + d)) = pack8_hw(v0, v1); }
        else if (col < 2304) { const int cc = col - 1280;
#pragma unroll
            for (int i = 0; i < 4; ++i) { v0[i] = gelu_tanh(v0[i]); v1[i] = gelu_tanh(v1[i]); }
            bf16* dst = cc < 512 ? zu + (size_t)row * 512 + cc : zv + (size_t)row * 512 + (cc - 512);
            *(u32x4*)dst = pack8_hw(v0, v1); }
        else if (col < 2328) {
#pragma unroll
            for (int i = 0; i < 4; ++i) { v0[i] = sigmoidf_(v0[i]); v1[i] = sigmoidf_(v1[i]); }
            float* dst = gates + (size_t)row * 24 + (col - 2304);
            *(f32x4*)dst = v0; *(f32x4*)(dst + 4) = v1; }
    }
    __device__ __forceinline__ void operator()(int row, int c0, int, f32x4 a0, f32x4 a1, f32x4 b0, f32x4 b1) const { one(row, c0, a0, a1); one(row, c0 + 128, b0, b1); }
};
struct FPlain { bf16* O; int ldc;
    __device__ __forceinline__ void operator()(int row, int c0, int, f32x4 a0, f32x4 a1, f32x4 b0, f32x4 b1) const {
        bf16* p = O + (size_t)row * ldc + c0; *(u32x4*)p = pack8(a0, a1); *(u32x4*)(p + 128) = pack8(b0, b1); }
};
struct FPart { float* O;
    __device__ __forceinline__ void operator()(int row, int c0, int, f32x4 a0, f32x4 a1, f32x4 b0, f32x4 b1) const {
        float* p = O + (size_t)row * 256 + c0; *(f32x4*)p = a0; *(f32x4*)(p + 4) = a1; *(f32x4*)(p + 128) = b0; *(f32x4*)(p + 132) = b1; }
};
struct FCmp { bf16* O; const float* b1p;
    __device__ __forceinline__ void operator()(int row, int c0, int, f32x4 a0, f32x4 a1, f32x4 b0, f32x4 b1) const {
        const f32x4 ba0 = *(const f32x4*)(b1p + c0), ba1 = *(const f32x4*)(b1p + c0 + 4), bb0 = *(const f32x4*)(b1p + c0 + 128), bb1 = *(const f32x4*)(b1p + c0 + 132);
#pragma unroll
        for (int i = 0; i < 4; ++i) { a0[i] = gelu_tanh(a0[i] + ba0[i]); a1[i] = gelu_tanh(a1[i] + ba1[i]); b0[i] = gelu_tanh(b0[i] + bb0[i]); b1[i] = gelu_tanh(b1[i] + bb1[i]); }
        bf16* p = O + (size_t)row * 256 + c0; *(u32x4*)p = pack8(a0, a1); *(u32x4*)(p + 128) = pack8(b0, b1); }
};
__device__ __forceinline__ float sumsq8(f32x4 a, f32x4 b) { return (a[0] * a[0] + a[1] * a[1]) + (a[2] * a[2] + a[3] * a[3]) + (b[0] * b[0] + b[1] * b[1]) + (b[2] * b[2] + b[3] * b[3]); }
struct FResA {
    const float* xi; bf16* xb; float* rss;
    typedef Pre4 Pre;
    __device__ __forceinline__ Pre pre(int row, int c0) const { const float* xp = xi + (size_t)row * DM + c0; Pre p; p.v[0] = *(const f32x4*)xp; p.v[1] = *(const f32x4*)(xp + 4); p.v[2] = *(const f32x4*)(xp + 128); p.v[3] = *(const f32x4*)(xp + 132); return p; }
    __device__ __forceinline__ void operator()(int row, int c0, int slot, f32x4 a0, f32x4 a1, f32x4 b0, f32x4 b1, const Pre& p) const {
        a0 += p.v[0]; a1 += p.v[1]; b0 += p.v[2]; b1 += p.v[3];
        bf16* bp = xb + (size_t)row * DM + c0; *(u32x4*)bp = pack8_hw(a0, a1); *(u32x4*)(bp + 128) = pack8_hw(b0, b1);
        float s = sumsq8(a0, a1) + sumsq8(b0, b1);
        s += __shfl_xor(s, 16); s += __shfl_xor(s, 32);
        if ((threadIdx.x & 63) < 16) rss[(size_t)row * 16 + slot] = s;
    }
};
struct PreB { u32x4 a, b; };
struct FResB {
    float* xo; bf16* xb; float* rss;
    typedef PreB Pre;
    __device__ __forceinline__ Pre pre(int row, int c0) const { const bf16* xp = xb + (size_t)row * DM + c0; Pre p; p.a = *(const u32x4*)xp; p.b = *(const u32x4*)(xp + 128); return p; }
    __device__ __forceinline__ void operator()(int row, int c0, int slot, f32x4 a0, f32x4 a1, f32x4 b0, f32x4 b1, const Pre& p) const {
        a0[0] += bflo(p.a.x); a0[1] += bfhi(p.a.x); a0[2] += bflo(p.a.y); a0[3] += bfhi(p.a.y); a1[0] += bflo(p.a.z); a1[1] += bfhi(p.a.z); a1[2] += bflo(p.a.w); a1[3] += bfhi(p.a.w);
        b0[0] += bflo(p.b.x); b0[1] += bfhi(p.b.x); b0[2] += bflo(p.b.y); b0[3] += bfhi(p.b.y); b1[0] += bflo(p.b.z); b1[1] += bfhi(p.b.z); b1[2] += bflo(p.b.w); b1[3] += bfhi(p.b.w);
        float* op = xo + (size_t)row * DM + c0;
        *(f32x4*)op = a0; *(f32x4*)(op + 4) = a1; *(f32x4*)(op + 128) = b0; *(f32x4*)(op + 132) = b1;
        bf16* bp = xb + (size_t)row * DM + c0; *(u32x4*)bp = pack8_hw(a0, a1); *(u32x4*)(bp + 128) = pack8_hw(b0, b1);
        float s = sumsq8(a0, a1) + sumsq8(b0, b1);
        s += __shfl_xor(s, 16); s += __shfl_xor(s, 32);
        if ((threadIdx.x & 63) < 16) rss[(size_t)row * 16 + slot] = s;
    }
};
__device__ __forceinline__ float row_rinv(const float* rss, int row) {
    const f32x4* p = (const f32x4*)(rss + (size_t)row * 16);
    const f32x4 a = p[0], b = p[1], c = p[2], d = p[3];
    const float s = ((a[0] + a[1]) + (a[2] + a[3])) + ((b[0] + b[1]) + (b[2] + b[3])) + ((c[0] + c[1]) + (c[2] + c[3])) + ((d[0] + d[1]) + (d[2] + d[3]));
    return __builtin_amdgcn_rsqf(s * (1.0f / DM) + EPS);
}
struct FFF1 { bf16* H; const float* rss;
    typedef Pre4 Pre;
    __device__ __forceinline__ Pre pre(int row, int) const { const f32x4* q = (const f32x4*)(rss + (size_t)row * 16); Pre p; p.v[0] = q[0]; p.v[1] = q[1]; p.v[2] = q[2]; p.v[3] = q[3]; return p; }
    __device__ __forceinline__ void operator()(int row, int c0, int, f32x4 a0, f32x4 a1, f32x4 b0, f32x4 b1, const Pre& pp) const {
        const float r = rinv_from(pp);
#pragma unroll
        for (int i = 0; i < 4; ++i) { float t;
            t = fmaxf(a0[i] * r, 0.f); a0[i] = t * t; t = fmaxf(a1[i] * r, 0.f); a1[i] = t * t;
            t = fmaxf(b0[i] * r, 0.f); b0[i] = t * t; t = fmaxf(b1[i] * r, 0.f); b1[i] = t * t; }
        bf16* p = H + (size_t)row * FF + c0; *(u32x4*)p = pack8_hw(a0, a1); *(u32x4*)(p + 128) = pack8_hw(b0, b1); }
};
struct FGate { float* xo; const bf16* tp; const float* rss;
    __device__ __forceinline__ void operator()(int row, int c0, int, f32x4 a0, f32x4 a1, f32x4 b0, f32x4 b1) const {
        const float r = row_rinv(rss, row);
        float* op = xo + (size_t)row * DM + c0;
        const u32x4 ta = *(const u32x4*)(tp + (size_t)row * DM + c0), tb = *(const u32x4*)(tp + (size_t)row * DM + c0 + 128);
        f32x4 x0 = *(f32x4*)op, x1 = *(f32x4*)(op + 4), y0 = *(f32x4*)(op + 128), y1 = *(f32x4*)(op + 132);
        x0[0] += sigmoidf_(a0[0] * r) * bflo(ta.x); x0[1] += sigmoidf_(a0[1] * r) * bfhi(ta.x); x0[2] += sigmoidf_(a0[2] * r) * bflo(ta.y); x0[3] += sigmoidf_(a0[3] * r) * bfhi(ta.y);
        x1[0] += sigmoidf_(a1[0] * r) * bflo(ta.z); x1[1] += sigmoidf_(a1[1] * r) * bfhi(ta.z); x1[2] += sigmoidf_(a1[2] * r) * bflo(ta.w); x1[3] += sigmoidf_(a1[3] * r) * bfhi(ta.w);
        y0[0] += sigmoidf_(b0[0] * r) * bflo(tb.x); y0[1] += sigmoidf_(b0[1] * r) * bfhi(tb.x); y0[2] += sigmoidf_(b0[2] * r) * bflo(tb.y); y0[3] += sigmoidf_(b0[3] * r) * bfhi(tb.y);
        y1[0] += sigmoidf_(b1[0] * r) * bflo(tb.z); y1[1] += sigmoidf_(b1[1] * r) * bfhi(tb.z); y1[2] += sigmoidf_(b1[2] * r) * bflo(tb.w); y1[3] += sigmoidf_(b1[3] * r) * bfhi(tb.w);
        *(f32x4*)op = x0; *(f32x4*)(op + 4) = x1; *(f32x4*)(op + 128) = y0; *(f32x4*)(op + 132) = y1;
    }
};
struct TpDeal {
    int bx, G;
    __device__ __forceinline__ bool next(int i, pg8::Unit& u) const {
        int k;
        if (G == 256) { if (bx < 128) { if (i != 0) return false; k = bx; } else { if (i >= 3) return false; k = 128 + (bx - 128) * 3 + i; } }
        else { k = bx + i * G; if (k >= 512) return false; }
        u.pm = k >> 2; u.pn = k & 3; return true;
    }
    __device__ __forceinline__ void a_ready(const pg8::Unit&) const {}
    __device__ __forceinline__ void done(const pg8::Unit&) const {}
};
struct OneUnit {
    int pm;
    __device__ __forceinline__ bool next(int i, pg8::Unit& u) const { if (i != 0 || pm < 0) return false; u.pm = pm; u.pn = 0; return true; }
    __device__ __forceinline__ void a_ready(const pg8::Unit&) const {}
    __device__ __forceinline__ void done(const pg8::Unit&) const {}
};

__device__ __forceinline__ void tr_item(const float* W, int ldw, int k0, int n0, bf16* WT, int ldt, int row0, const float* gain, LAS float* scr, int lane) {
#pragma unroll 8
    for (int i = 0; i < 32; ++i) { const int kk = 2 * i + (lane >> 5); float v = W[(size_t)(k0 + kk) * ldw + n0 + (lane & 31)]; if (gain) v *= gain[k0 + kk]; scr[kk * 33 + (lane & 31)] = v; }
    asm volatile("s_waitcnt lgkmcnt(0)" ::: "memory");
    const int c = lane & 7;
#pragma unroll
    for (int j = 0; j < 4; ++j) { const int n = (lane >> 3) + 8 * j; const LAS float* s = scr + (8 * c) * 33 + n;
        u32x4 o; o.x = pk2(s[0 * 33], s[1 * 33]); o.y = pk2(s[2 * 33], s[3 * 33]); o.z = pk2(s[4 * 33], s[5 * 33]); o.w = pk2(s[6 * 33], s[7 * 33]);
        *(u32x4*)(WT + (size_t)(row0 + n) * ldt + k0 + 8 * c) = o; }
    asm volatile("s_waitcnt lgkmcnt(0)" ::: "memory");
}

namespace att {
constexpr int KROW = 144, VROW = 136, KSZ = 64 * KROW, VSZ = 64 * VROW, BUFSZ = KSZ + VSZ;
constexpr int OFF_K = 0, OFF_V = KSZ, OFF_IMP = 2 * BUFSZ, IMPW = 8 * 65 * 4, OFF_RS = OFF_IMP + 8 * IMPW, OFF_UM = OFF_RS + 512, OFF_TL = OFF_UM + 64, OFF_TN = OFF_TL + 512, OFF_Q = OFF_TN + 64, OFF_STG = OFF_Q + 8 * 4096, OFF_OUT = OFF_STG + 8 * 4096, ATT_END = OFF_OUT + 8 * 4096;
static_assert(ATT_END <= LDS_BYTES - 64 && OFF_Q % 16 == 0 && OFF_IMP % 16 == 0 && BUFSZ % 16 == 0, "attention LDS");
}
#define XB_TMO      128
#define XB_XCNT(j)  (256  + 64 * (j))
#define XB_XSUB(j)  (1280 + 64 * (j))
#define XB_XGEN(j)  (2304 + 64 * (j))
#define XB_TOP      3328
#define XB_TOPGEN   3392
#define XCD_BAR_WORDS 3456
#define XB_SPIN_CAP (1u << 22)

__device__ __forceinline__ unsigned xb_ld(unsigned* p)              { return __hip_atomic_load(p, __ATOMIC_RELAXED, __HIP_MEMORY_SCOPE_AGENT); }
__device__ __forceinline__ unsigned xb_add(unsigned* p, unsigned v) { return __hip_atomic_fetch_add(p, v, __ATOMIC_RELAXED, __HIP_MEMORY_SCOPE_AGENT); }
__device__ __forceinline__ unsigned xb_xcc_id() { return (unsigned)__builtin_amdgcn_s_getreg((3 << 11) | 20) & 0xFu; }
#define XB_SPIN(cond, bar) do { unsigned _sp = 0; while (cond) { __builtin_amdgcn_s_sleep(1); \
    if ((++_sp & 255u) == 0u) { if (xb_ld(&(bar)[XB_TMO])) break; if (_sp > XB_SPIN_CAP) { atomicAdd(&(bar)[XB_TMO], 1u); break; } } } } while (0)

struct XcdBarrier {
    unsigned* bar; unsigned x;
    volatile LAS unsigned* st;
};

__device__ __forceinline__ XcdBarrier xcd_barrier_post(unsigned* bar, volatile LAS unsigned* st) {
    XcdBarrier b; b.bar = bar; b.x = xb_xcc_id(); b.st = st;
    if (threadIdx.x == 0) (void)xb_add(&bar[XB_XCNT(b.x)], 1u);
    return b;
}
__device__ __forceinline__ void xcd_barrier_complete(unsigned* bar, unsigned x, unsigned& nloc, unsigned& nx) {
    const unsigned G = gridDim.x * gridDim.y * gridDim.z;
    unsigned sum, cnt, mine, sp = 0u;
    for (;;) {
        sum = 0u; cnt = 0u; mine = 0u;
#pragma unroll
        for (unsigned j = 0; j < 16; ++j) { const unsigned c = xb_ld(&bar[XB_XCNT(j)]); sum += c; cnt += (c > 0u) ? 1u : 0u; mine = (j == x) ? c : mine; }
        if (sum == G) break;
        __builtin_amdgcn_s_sleep(1);
        if ((++sp & 255u) == 0u) { if (xb_ld(&bar[XB_TMO])) break; if (sp > XB_SPIN_CAP) { atomicAdd(&bar[XB_TMO], 1u); break; } }
    }
    nloc = mine > 0u ? mine : 1u; nx = cnt > 0u ? cnt : 1u;
}

__device__ __forceinline__ void xcd_barrier(const XcdBarrier& b) {
    asm volatile("s_waitcnt vmcnt(0)" ::: "memory");
    __syncthreads();
    if (threadIdx.x == 0) {
        unsigned* bar = b.bar;
        __builtin_amdgcn_s_waitcnt(0);
        unsigned nloc = b.st[0], nx = b.st[1];
        if (nloc == 0u) { xcd_barrier_complete(bar, b.x, nloc, nx); b.st[0] = nloc; b.st[1] = nx; }
        const unsigned old = xb_add(&bar[XB_XSUB(b.x)], 1u);
        const unsigned gen = old / nloc;
        if (old + 1u == (gen + 1u) * nloc) {
            __builtin_amdgcn_fence(__ATOMIC_RELEASE, "agent");
            asm volatile("s_waitcnt vmcnt(0)" ::: "memory");
            const unsigned og = xb_add(&bar[XB_TOP], 1u);
            const unsigned tg = og / nx;
            if (og + 1u == (tg + 1u) * nx) xb_add(&bar[XB_TOPGEN], 1u);
            else XB_SPIN(xb_ld(&bar[XB_TOPGEN]) == tg, bar);
            __builtin_amdgcn_fence(__ATOMIC_ACQUIRE, "agent");
            xb_add(&bar[XB_XGEN(b.x)], 1u);
            asm volatile("s_waitcnt vmcnt(0)" ::: "memory");
        } else {
            XB_SPIN(xb_ld(&bar[XB_XGEN(b.x)]) == gen, bar);
            __builtin_amdgcn_fence(__ATOMIC_ACQUIRE, "agent");
            asm volatile("s_waitcnt vmcnt(0)" ::: "memory");
        }
    }
    __syncthreads();
}

namespace att {
#define NEG_INF (-__builtin_inff())
#define SBAR_() __builtin_amdgcn_sched_barrier(0)
__device__ __forceinline__ float rowmax32(const f32x16 (&s)[2]) {
    float mx = s[0][0];
#pragma unroll
    for (int kb = 0; kb < 2; ++kb)
#pragma unroll
        for (int i = 0; i < 16; ++i) mx = fmaxf(mx, s[kb][i]);
    return fmaxf(mx, __shfl_xor(mx, 32));
}
typedef float f32x2v __attribute__((ext_vector_type(2)));
__device__ __forceinline__ float exp_sub_sum(f32x16 (&s)[2], float c) {
    const f32x2v cc = {c, c}; f32x2v acc = {0.f, 0.f};
#pragma unroll
    for (int kb = 0; kb < 2; ++kb)
#pragma unroll
        for (int i = 0; i < 16; i += 2) {
            f32x2v d = {s[kb][i], s[kb][i + 1]}; d = d - cc;
            f32x2v p; p.x = __builtin_amdgcn_exp2f(d.x); p.y = __builtin_amdgcn_exp2f(d.y);
            s[kb][i] = p.x; s[kb][i + 1] = p.y; acc = acc + p;
        }
    return acc.x + acc.y;
}
__device__ __forceinline__ void exp_sub_scale(f32x16 (&s)[2], float c, float sc) {
    const f32x2v cc = {c, c}, ss = {sc, sc};
#pragma unroll
    for (int kb = 0; kb < 2; ++kb)
#pragma unroll
        for (int i = 0; i < 16; i += 2) {
            f32x2v d = {s[kb][i], s[kb][i + 1]}; d = d - cc;
            f32x2v p; p.x = __builtin_amdgcn_exp2f(d.x); p.y = __builtin_amdgcn_exp2f(d.y); p = p * ss;
            s[kb][i] = p.x; s[kb][i + 1] = p.y;
        }
}
__device__ __forceinline__ void stats_update(f32x16 (&s)[2], float& m, float& l, float base) {
    const float mx = rowmax32(s) + base, mn = fmaxf(m, mx), mu = (mn == NEG_INF) ? 0.f : mn;
    const float alpha = __builtin_amdgcn_exp2f(m - mu), c = mu - base;
    const float sum = exp_sub_sum(s, c);
    l = l * alpha + sum; m = mn;
}
template <int MUL, bool CAUSAL, bool LOWER>
__device__ __forceinline__ void scores(f32x16 (&s)[2], const bf16x8 qx, const LAS unsigned char* qL, const LAS unsigned char* Kg, int l32, int hi, int limHi, int limLo) {
    bf16x8 q[4];
#pragma unroll
    for (int ks = 0; ks < 4; ++ks) q[ks] = *(const LAS bf16x8*)(qL + ks * 1024);
    __builtin_amdgcn_s_setprio(1);
#pragma unroll
    for (int kb = 0; kb < 2; ++kb) {
        f32x16 a;
        {
            const unsigned kl = (hi == 0) ? (unsigned)__builtin_bit_cast(unsigned short, (__bf16)(float)(kb * 32 + l32)) * 0x10001u : 0u;
            u32x4 kw; kw.x = kl; kw.y = 0u; kw.z = 0u; kw.w = 0u;
            f32x16 z;
#pragma unroll
            for (int i = 0; i < 16; ++i) z[i] = 0.f;
            a = __builtin_amdgcn_mfma_f32_32x32x16_bf16(__builtin_bit_cast(bf16x8, kw), qx, z, 0, 0, 0);
        }
#pragma unroll
        for (int ks = 0; ks < 4; ++ks) {
            const bf16x8 kf = *(const LAS bf16x8*)(Kg + (kb * 32 + l32) * KROW + ks * 32 + hi * 16);
            a = __builtin_amdgcn_mfma_f32_32x32x16_bf16(kf, q[ks], a, 0, 0, 0);
        }
        if (CAUSAL || LOWER) {
#pragma unroll
            for (int i = 0; i < 16; ++i) {
                const int ci = kb * 32 + (i & 3) + 8 * (i >> 2);
                if (CAUSAL) { if (ci * MUL > limHi) a[i] = NEG_INF; }
                if (LOWER) { if (ci <= limLo) a[i] = NEG_INF; }
            }
        }
        s[kb] = a;
    }
    __builtin_amdgcn_s_setprio(0);
}
__device__ __forceinline__ bf16x8 make_qx(float slope, int hi) {
    const __bf16 h = (__bf16)slope; const __bf16 lo = (__bf16)(slope - (float)h);
    const unsigned v = (unsigned)__builtin_bit_cast(unsigned short, h) | ((unsigned)__builtin_bit_cast(unsigned short, lo) << 16);
    u32x4 w; w.x = (hi == 0) ? v : 0u; w.y = 0u; w.z = 0u; w.w = 0u;
    return __builtin_bit_cast(bf16x8, w);
}
__device__ __forceinline__ void online(f32x16 (&s)[2], f32x16 (&o)[2], float& m, float& l, float base) {
    const float mx = rowmax32(s) + base, mn = fmaxf(m, mx), mu = (mn == NEG_INF) ? 0.f : mn;
    const float alpha = __builtin_amdgcn_exp2f(m - mu), c = mu - base;
    const float sum = exp_sub_sum(s, c);
    l = l * alpha + sum; m = mn;
    if (__builtin_amdgcn_ballot_w64(alpha != 1.0f) != 0ull) {
#pragma unroll
        for (int db = 0; db < 2; ++db)
#pragma unroll
            for (int i = 0; i < 16; ++i) o[db][i] *= alpha;
    }
}
__device__ __forceinline__ void pack_p(bf16x8 (&pk)[4], const f32x16 (&s)[2]) {
#pragma unroll
    for (int kk = 0; kk < 4; ++kk) {
        const int kb = kk >> 1, i0 = (kk & 1) * 8;
        u32x4 w; w.x = pk2_hw(s[kb][i0], s[kb][i0 + 1]); w.y = pk2_hw(s[kb][i0 + 2], s[kb][i0 + 3]); w.z = pk2_hw(s[kb][i0 + 4], s[kb][i0 + 5]); w.w = pk2_hw(s[kb][i0 + 6], s[kb][i0 + 7]);
        pk[kk] = __builtin_bit_cast(bf16x8, w);
    }
}
__device__ __forceinline__ void pv(f32x16 (&o)[2], const bf16x8 (&pk)[4], const LAS unsigned char* Vg, int l32, int hi) {
    __builtin_amdgcn_s_setprio(1);
#pragma unroll
    for (int db = 0; db < 2; ++db)
#pragma unroll
        for (int kk = 0; kk < 4; ++kk) {
            const LAS unsigned char* p = Vg + (db * 32 + l32) * VROW + (kk * 16 + hi * 4) * 2;
            const u32x2 lo = *(const LAS u32x2*)p, hh = *(const LAS u32x2*)(p + 16);
            u32x4 w; w.x = lo.x; w.y = lo.y; w.z = hh.x; w.w = hh.y;
            const bf16x8 vf = __builtin_bit_cast(bf16x8, w);
            o[db] = __builtin_amdgcn_mfma_f32_32x32x16_bf16(vf, pk[kk], o[db], 0, 0, 0);
        }
    __builtin_amdgcn_s_setprio(0);
}

__device__ __forceinline__ void attn_pass(LAS unsigned char* lds, int b, int qb, int g, const float* qng, const bf16* zq, const bf16* kvb, const bf16* kc, const bf16* vc, const float* gates, bf16* mix) {
    int tid_ = threadIdx.x; asm volatile("" : "+v"(tid_));
    const int tid = tid_, lane = tid & 63, w = __builtin_amdgcn_readfirstlane(tid >> 6), l32_ = lane & 31, hi_ = lane >> 5, qi = lane & 7, hh = l32_ >> 3;
    const int q0 = qb * 64, t = q0 + 8 * w + qi, row = b * 4096 + t, head = g * 4 + hh;
    const size_t gb = (size_t)(b * 2 + g);
    const bf16* ksb = kvb + 2 * KV_STRIDE + gb * 4096 * 64; const bf16* vsb = kvb + 3 * KV_STRIDE + gb * 4096 * 64;
    const bf16* kwb = kvb + 4 * KV_STRIDE + gb * 4096 * 64; const bf16* vwb = kvb + 5 * KV_STRIDE + gb * 4096 * 64;
    const bf16* kcb = kc + gb * 256 * 64; const bf16* vcb = vc + gb * 256 * 64;
    LAS int* TL = (LAS int*)(lds + OFF_TL); LAS int* TN = (LAS int*)(lds + OFF_TN); LAS unsigned* UM = (LAS unsigned*)(lds + OFF_UM); LAS float* SS = (LAS float*)(lds + OFF_RS);
    LAS float* impw = (LAS float*)(lds + OFF_IMP + w * IMPW);
    const int ntc = min(4, (((q0 + 32) >> 4) >> 6) + 1);
    LAS unsigned char* qW_ = lds + OFF_Q + w * 4096 + lane * 16;
    {
        const bf16* qp = zq + (size_t)row * 512 + head * 64 + hi_ * 8;
        u32x4 qv[4]; float ssq = 0.f;
#pragma unroll
        for (int ks = 0; ks < 4; ++ks) { qv[ks] = *(const u32x4*)(qp + ks * 16);
            const float f0 = bflo(qv[ks].x), f1 = bfhi(qv[ks].x), f2 = bflo(qv[ks].y), f3 = bfhi(qv[ks].y), f4 = bflo(qv[ks].z), f5 = bfhi(qv[ks].z), f6 = bflo(qv[ks].w), f7 = bfhi(qv[ks].w);
            ssq += ((f0 * f0 + f1 * f1) + (f2 * f2 + f3 * f3)) + ((f4 * f4 + f5 * f5) + (f6 * f6 + f7 * f7)); }
        ssq += __shfl_xor(ssq, 32);
        const float rq = __builtin_amdgcn_rsqf(ssq * (1.0f / 64.0f) + EPS) * QSCALE;
#pragma unroll
        for (int ks = 0; ks < 4; ++ks) {
            const f32x4 g0 = *(const f32x4*)(qng + ks * 16 + hi_ * 8), g1 = *(const f32x4*)(qng + ks * 16 + hi_ * 8 + 4);
            u32x4 wv;
            wv.x = pk2_hw(bflo(qv[ks].x) * rq * g0[0], bfhi(qv[ks].x) * rq * g0[1]); wv.y = pk2_hw(bflo(qv[ks].y) * rq * g0[2], bfhi(qv[ks].y) * rq * g0[3]);
            wv.z = pk2_hw(bflo(qv[ks].z) * rq * g1[0], bfhi(qv[ks].z) * rq * g1[1]); wv.w = pk2_hw(bflo(qv[ks].w) * rq * g1[2], bfhi(qv[ks].w) * rq * g1[3]);
            *(LAS u32x4*)(qW_ + ks * 1024) = wv;
        }
    }
    const float slope2 = LOG2E / (float)(2 << head);
    if (tid == 0) { int n = 0; for (int j = 0; j < ntc; ++j) TL[n++] = j; for (int j = 0; j < ntc; ++j) TL[n++] = (1 << 8) | j;
        const int j0 = qb >= 8 ? qb - 8 : 0; for (int jw = qb; jw >= j0; --jw) TL[n++] = (4 << 8) | jw; TN[0] = n; }
    __syncthreads();
    f32x16 o[2]; bf16x8 qx;
#pragma unroll
    for (int a = 0; a < 2; ++a)
#pragma unroll
        for (int i = 0; i < 16; ++i) o[a][i] = 0.f;
    qx = make_qx(16.f * slope2, hi_);
    float m = NEG_INF, l = 0.f, mc = 0.f, ilc = 0.f;
    LAS unsigned char* stg = lds + OFF_STG + w * 4096 + lane * 16;
    unsigned sel_lo = 0xffffffffu, sel_hi = 0xffffffffu, un_lo = 0xffffffffu, un_hi = 0xffffffffu;
    const int skey = tid >> 3, spart = tid & 7, soff = skey * 64 + spart * 8;
    u32x4 pfk, pfv;
#define ATT_ISSUE(code) do { const int _k = (code) >> 8, _j = (code) & 255; \
        const bf16* _kp = (_k == 2) ? ksb + (size_t)_j * 4096 : (_k == 4) ? kwb + (size_t)_j * 4096 : kcb + (size_t)_j * 4096; \
        pfk = *(const u32x4*)(_kp + soff); \
        if (_k == 2 || _k == 4 || _k == 1) { const bf16* _vp = (_k == 2) ? vsb + (size_t)_j * 4096 : (_k == 4) ? vwb + (size_t)_j * 4096 : vcb + (size_t)_j * 4096; pfv = *(const u32x4*)(_vp + soff); } } while (0)
#define ATT_COMMIT(code, par) do { const int _k = (code) >> 8; LAS unsigned char* _b = lds + (par) * BUFSZ; \
        *(LAS u32x4*)(_b + OFF_K + skey * KROW + spart * 16) = pfk; \
        if (_k == 2 || _k == 4 || _k == 1) { LAS unsigned char* _d = _b + OFF_V + skey * VROW + spart * 16; \
            u32x2 _lo, _hi; _lo.x = pfv.x; _lo.y = pfv.y; _hi.x = pfv.z; _hi.y = pfv.w; *(LAS u32x2*)_d = _lo; *(LAS u32x2*)(_d + 8) = _hi; } } while (0)
#define ATT_REAL(code) ((code) >= 0 && ((code) >> 8) != 6)

    int idx = 0, n = TN[0], par = 0, prevk = -1;
    { const int c0 = TL[0]; ATT_ISSUE(c0); ATT_COMMIT(c0, 0); const int c1 = TL[1]; ATT_ISSUE(c1); }
    __syncthreads();
    for (;;) {
        const int cur = TL[idx];
        const int kind = cur >> 8, j = cur & 255;
        int l32 = l32_, hi = hi_; asm volatile("" : "+v"(l32), "+v"(hi));
        const LAS unsigned char* qW = qW_;
        const LAS unsigned char* Kg = lds + par * BUFSZ + OFF_K; const LAS unsigned char* Vg = lds + par * BUFSZ + OFF_V;
        if (kind != prevk) {
            if (prevk == 0) {
                const float lt = l + __shfl_xor(l, 32); ilc = lt > 0.f ? 1.0f / lt : 0.f; mc = (m == NEG_INF) ? 0.f : m;
                for (int k = lane; k < 8 * 65; k += 64) impw[k] = 0.f;
            }
            if (kind == 4) {
                {
                const int n_old = n;
                unsigned lo = 0xffffffffu, hw = 0xffffffffu;
                if (qb >= 16) {
                    const int part = lane >> 3;
                    float mine[8]; int rank[8];
#pragma unroll
                    for (int k = 0; k < 8; ++k) { mine[k] = impw[qi * 65 + part * 8 + k]; rank[k] = 0; }
#pragma unroll 4
                    for (int i = 1; i <= qb - 2; ++i) {
                        const float v = impw[qi * 65 + i];
#pragma unroll
                        for (int k = 0; k < 8; ++k) { const int js = part * 8 + k; rank[k] += ((v > mine[k]) || (v == mine[k] && i < js)) ? 1 : 0; }
                    }
                    unsigned bits = 0;
#pragma unroll
                    for (int k = 0; k < 8; ++k) { const int js = part * 8 + k;
                        const bool sel = (js == 0) || (js == qb - 1) || (js == qb) || (js >= 1 && js <= qb - 2 && rank[k] < 13);
                        bits |= sel ? (1u << k) : 0u; }
                    lo = (part < 4) ? (bits << (8 * part)) : 0u;
                    hw = (part >= 4) ? (bits << (8 * (part - 4))) : 0u;
#pragma unroll
                    for (int of = 8; of < 64; of <<= 1) { lo |= __shfl_xor(lo, of); hw |= __shfl_xor(hw, of); }
                }
                sel_lo = lo; sel_hi = hw;
                unsigned ulo = lo, uhi = hw;
#pragma unroll
                for (int of = 1; of < 8; of <<= 1) { ulo |= __shfl_xor(ulo, of); uhi |= __shfl_xor(uhi, of); }
                un_lo = __builtin_amdgcn_readfirstlane(ulo); un_hi = __builtin_amdgcn_readfirstlane(uhi);
                if (lane == 0) { UM[w * 2] = un_lo; UM[w * 2 + 1] = un_hi; }
                __syncthreads();
                if (tid == 0) {
                    unsigned a = 0, c = 0; for (int k = 0; k < 8; ++k) { a |= UM[2 * k]; c |= UM[2 * k + 1]; }
                    int nn = TN[0];
                    for (int js = qb; js >= 0; --js) { const bool on = js < 32 ? ((a >> js) & 1u) : ((c >> (js - 32)) & 1u); if (on) TL[nn++] = (2 << 8) | js; }
                    TN[0] = nn;
                }
                __syncthreads();
                n = TN[0];
                if (idx + 1 >= n_old && idx + 1 < n) { const int c1 = TL[idx + 1]; ATT_ISSUE(c1); }
                }
                qx = make_qx(slope2, hi_);
                const float gc = gates[(size_t)row * 24 + head * 3];
#pragma unroll
                for (int db = 0; db < 2; ++db)
#pragma unroll
                    for (int i4 = 0; i4 < 2; ++i4) {
                        u32x4 wv;
                        wv.x = pk2_hw(o[db][8 * i4 + 0] * gc, o[db][8 * i4 + 1] * gc); wv.y = pk2_hw(o[db][8 * i4 + 2] * gc, o[db][8 * i4 + 3] * gc);
                        wv.z = pk2_hw(o[db][8 * i4 + 4] * gc, o[db][8 * i4 + 5] * gc); wv.w = pk2_hw(o[db][8 * i4 + 6] * gc, o[db][8 * i4 + 7] * gc);
                        *(LAS u32x4*)(stg + (db * 2 + i4) * 1024) = wv;
                    }
#pragma unroll
                for (int db = 0; db < 2; ++db)
#pragma unroll
                    for (int i = 0; i < 16; ++i) o[db][i] = 0.f;
            }
            if (prevk == 4) {
                const float lt = l + __shfl_xor(l, 32); const float sc = lt > 0.f ? gates[(size_t)row * 24 + head * 3 + 2] / lt : 0.f;
#pragma unroll
                for (int db = 0; db < 2; ++db)
#pragma unroll
                    for (int i4 = 0; i4 < 2; ++i4) {
                        const u32x4 pv_ = *(const LAS u32x4*)(stg + (db * 2 + i4) * 1024);
                        u32x4 wv;
                        wv.x = pk2_hw(o[db][8 * i4 + 0] * sc + bflo(pv_.x), o[db][8 * i4 + 1] * sc + bfhi(pv_.x)); wv.y = pk2_hw(o[db][8 * i4 + 2] * sc + bflo(pv_.y), o[db][8 * i4 + 3] * sc + bfhi(pv_.y));
                        wv.z = pk2_hw(o[db][8 * i4 + 4] * sc + bflo(pv_.z), o[db][8 * i4 + 5] * sc + bfhi(pv_.z)); wv.w = pk2_hw(o[db][8 * i4 + 6] * sc + bflo(pv_.w), o[db][8 * i4 + 7] * sc + bfhi(pv_.w));
                        *(LAS u32x4*)(stg + (db * 2 + i4) * 1024) = wv;
                    }
#pragma unroll
                for (int db = 0; db < 2; ++db)
#pragma unroll
                    for (int i = 0; i < 16; ++i) o[db][i] = 0.f;
            }
            m = NEG_INF; l = 0.f;
            prevk = kind;
        }
        const int nxt = (idx + 1 < n) ? TL[idx + 1] : -1;
        if (nxt >= 0) { ATT_COMMIT(nxt, par ^ 1); const int nn = (idx + 2 < n) ? TL[idx + 2] : -1; if (nn >= 0) ATT_ISSUE(nn); }
        if (kind == 0 || kind == 1) {
            f32x16 s[2];
            scores<16, true, false>(s, qx, qW, Kg, l32, hi, t - 31 - 1024 * j - 64 * hi, 0);
            const float base = -slope2 * ((float)(t - 1024 * j - 64 * hi) - 15.5f);
            if (kind == 0) stats_update(s, m, l, base);
            else {
                exp_sub_scale(s, mc - base, ilc);
                { bf16x8 pk[4]; pack_p(pk, s); SBAR_(); pv(o, pk, Vg, l32, hi); SBAR_(); }
#pragma unroll
                for (int kb = 0; kb < 2; ++kb)
#pragma unroll
                    for (int i = 0; i < 16; ++i) { float v = s[kb][i]; v += __shfl_xor(v, 8); v += __shfl_xor(v, 16); s[kb][i] = v; }
                if (l32_ < 8) {
#pragma unroll
                    for (int kb = 0; kb < 2; ++kb)
#pragma unroll
                        for (int a = 0; a < 4; ++a) {
                            const int js = 16 * j + 8 * kb + 2 * a + hi;
                            const float p3 = s[kb][4 * a + 3], mainv = 2.f * (s[kb][4 * a] + s[kb][4 * a + 1] + s[kb][4 * a + 2]) + p3;
                            impw[qi * 65 + js] += mainv;
                            impw[qi * 65 + js + 1] += p3;
                        }
                }
            }
        } else if (kind == 2) {
            const bool need = (j < 32) ? ((un_lo >> j) & 1u) : ((un_hi >> (j - 32)) & 1u);
            if (need) {
                const bool selbit = (j < 32) ? ((sel_lo >> j) & 1u) : ((sel_hi >> (j - 32)) & 1u);
                f32x16 s[2];
                if (j == qb) scores<1, true, false>(s, qx, qW, Kg, l32, hi, t - 64 * j - 4 * hi, 0);
                else scores<1, false, false>(s, qx, qW, Kg, l32, hi, 0, 0);
                online(s, o, m, l, selbit ? -slope2 * (float)(t - 64 * j - 4 * hi) : NEG_INF);
                bf16x8 pk[4]; pack_p(pk, s); SBAR_(); pv(o, pk, Vg, l32, hi);
            }
        } else if (kind == 4) {
            f32x16 s[2];
            if (j == qb) scores<1, true, false>(s, qx, qW, Kg, l32, hi, t - 64 * j - 4 * hi, 0);
            else if (j == qb - 8) scores<1, false, true>(s, qx, qW, Kg, l32, hi, 0, t - 512 - 64 * j - 4 * hi);
            else scores<1, false, false>(s, qx, qW, Kg, l32, hi, 0, 0);
            online(s, o, m, l, -slope2 * (float)(t - 64 * j - 4 * hi));
            bf16x8 pk[4]; pack_p(pk, s); SBAR_(); pv(o, pk, Vg, l32, hi);
        }
        __syncthreads();
        ++idx; par ^= 1;
        if (nxt < 0) break;
    }
    {
        const float lt = l + __shfl_xor(l, 32); const float sc = lt > 0.f ? gates[(size_t)row * 24 + head * 3 + 1] / lt : 0.f;
#pragma unroll
        for (int db = 0; db < 2; ++db)
#pragma unroll
            for (int i4 = 0; i4 < 2; ++i4) {
                const u32x4 wv = *(const LAS u32x4*)(stg + (db * 2 + i4) * 1024);
                o[db][8 * i4 + 0] = o[db][8 * i4 + 0] * sc + bflo(wv.x); o[db][8 * i4 + 1] = o[db][8 * i4 + 1] * sc + bfhi(wv.x);
                o[db][8 * i4 + 2] = o[db][8 * i4 + 2] * sc + bflo(wv.y); o[db][8 * i4 + 3] = o[db][8 * i4 + 3] * sc + bfhi(wv.y);
                o[db][8 * i4 + 4] = o[db][8 * i4 + 4] * sc + bflo(wv.z); o[db][8 * i4 + 5] = o[db][8 * i4 + 5] * sc + bfhi(wv.z);
                o[db][8 * i4 + 6] = o[db][8 * i4 + 6] * sc + bflo(wv.w); o[db][8 * i4 + 7] = o[db][8 * i4 + 7] * sc + bfhi(wv.w);
            }
    }
    float ss = 0.f;
#pragma unroll
    for (int db = 0; db < 2; ++db)
#pragma unroll
        for (int i = 0; i < 16; ++i) ss += o[db][i] * o[db][i];
    ss += __shfl_xor(ss, 8); ss += __shfl_xor(ss, 16); ss += __shfl_xor(ss, 32);
    if (lane < 8) SS[g * 64 + 8 * w + lane] = ss;
    LAS unsigned char* outp = lds + OFF_OUT + w * 4096 + lane * 16;
    if (g == 0) {
#pragma unroll
        for (int db = 0; db < 2; ++db)
#pragma unroll
            for (int i4 = 0; i4 < 2; ++i4) {
                u32x4 wv; wv.x = pk2_hw(o[db][8 * i4 + 0], o[db][8 * i4 + 1]); wv.y = pk2_hw(o[db][8 * i4 + 2], o[db][8 * i4 + 3]); wv.z = pk2_hw(o[db][8 * i4 + 4], o[db][8 * i4 + 5]); wv.w = pk2_hw(o[db][8 * i4 + 6], o[db][8 * i4 + 7]);
                *(LAS u32x4*)(outp + (db * 2 + i4) * 1024) = wv;
            }
        __syncthreads();
    } else {
        __syncthreads();
        const float rinv = __builtin_amdgcn_rsqf((SS[8 * w + qi] + SS[64 + 8 * w + qi]) * (1.0f / 512.0f) + EPS);
        bf16* op1 = mix + (size_t)row * DM + (4 + hh) * 64 + 4 * hi_;
        bf16* op0 = mix + (size_t)row * DM + hh * 64 + 4 * hi_;
#pragma unroll
        for (int db = 0; db < 2; ++db)
#pragma unroll
            for (int a = 0; a < 4; ++a) {
                u32x2 wv; wv.x = pk2_hw(o[db][4 * a] * rinv, o[db][4 * a + 1] * rinv); wv.y = pk2_hw(o[db][4 * a + 2] * rinv, o[db][4 * a + 3] * rinv);
                *(u32x2*)(op1 + db * 32 + 8 * a) = wv;
            }
#pragma unroll
        for (int db = 0; db < 2; ++db)
#pragma unroll
            for (int i4 = 0; i4 < 2; ++i4) {
                const u32x4 v = *(const LAS u32x4*)(outp + (db * 2 + i4) * 1024);
                u32x2 w0, w1; w0.x = pk2_hw(bflo(v.x) * rinv, bfhi(v.x) * rinv); w0.y = pk2_hw(bflo(v.y) * rinv, bfhi(v.y) * rinv); w1.x = pk2_hw(bflo(v.z) * rinv, bfhi(v.z) * rinv); w1.y = pk2_hw(bflo(v.w) * rinv, bfhi(v.w) * rinv);
                *(u32x2*)(op0 + db * 32 + 8 * (2 * i4)) = w0; *(u32x2*)(op0 + db * 32 + 8 * (2 * i4 + 1)) = w1;
            }
        __syncthreads();
    }
#undef ATT_ISSUE
#undef ATT_COMMIT
#undef ATT_REAL
}
__device__ __forceinline__ void attn_item(LAS unsigned char* lds, int b, int qb, const float* qng, const bf16* zq, const bf16* kvb, const bf16* kc, const bf16* vc, const float* gates, bf16* mix) {
#pragma nounroll
    for (int g = 0; g < 2; ++g) attn_pass(lds, b, qb, g, qng, zq, kvb, kc, vc, gates, mix);
}
}
#ifndef PHASES
#define PHASES 0x1ff
#endif

__device__ __forceinline__ void gmlp_item(LAS unsigned char* lds, int item, const bf16* zu, const bf16* zv, bf16* mix, const float* ln_g, const float* ln_b, const bf16* wsb, const float* gbs) {
    int tid_ = threadIdx.x; asm volatile("" : "+v"(tid_));
    const int tid = tid_, lane = tid & 63, w = __builtin_amdgcn_readfirstlane(tid >> 6);
    const int r0 = item * 128;
    constexpr int WROW = 272;
    LAS unsigned char* VT = lds;
    u32x2 uall[8][4];
    {
        const bf16* up = zu + (size_t)(r0 + 16 * w + (lane & 15)) * 512 + (lane >> 4) * 4;
#pragma unroll
        for (int g = 0; g < 8; ++g)
#pragma unroll
            for (int nb = 0; nb < 4; ++nb) uall[g][nb] = *(const u32x2*)(up + g * 64 + nb * 16);
    }
    {
        f32x4 g0 = *(const f32x4*)(ln_g + lane * 8), g1 = *(const f32x4*)(ln_g + lane * 8 + 4), b0 = *(const f32x4*)(ln_b + lane * 8), b1 = *(const f32x4*)(ln_b + lane * 8 + 4);
#pragma unroll 4
        for (int k = 0; k < 16; ++k) {
            const int tl = w * 16 + k;
            const u32x4 v = *(const u32x4*)(zv + (size_t)(r0 + tl) * 512 + lane * 8);
            float f[8] = {bflo(v.x), bfhi(v.x), bflo(v.y), bfhi(v.y), bflo(v.z), bfhi(v.z), bflo(v.w), bfhi(v.w)};
            float s = ((f[0] + f[1]) + (f[2] + f[3])) + ((f[4] + f[5]) + (f[6] + f[7]));
            float s2 = ((f[0] * f[0] + f[1] * f[1]) + (f[2] * f[2] + f[3] * f[3])) + ((f[4] * f[4] + f[5] * f[5]) + (f[6] * f[6] + f[7] * f[7]));
            s = wave_sum(s); s2 = wave_sum(s2);
            const float mean = s * (1.0f / 512.0f), var = fmaxf(s2 * (1.0f / 512.0f) - mean * mean, 0.f), rs = __builtin_amdgcn_rsqf(var + EPS);
#pragma unroll
            for (int e = 0; e < 8; ++e) {
                const float gg = e < 4 ? g0[e] : g1[e - 4], bb = e < 4 ? b0[e] : b1[e - 4];
                *(LAS unsigned short*)(VT + (lane * 8 + e) * WROW + (((tl >> 3) ^ (lane & 7)) << 4) + (tl & 7) * 2) = (unsigned short)f2bf((f[e] - mean) * rs * gg + bb);
            }
        }
    }
    __syncthreads();
    const int tl = 16 * w + (lane & 15), fq = lane >> 4;
    const int nks = (16 * w + 15) / 32 + 1;
    float ssq = 0.f;
    u32x2 oall[8][4];
    bf16x8 nb_fr[4]; float nbias;
#define GMLP_FETCH(g_) do { const bf16* wrow_ = wsb + ((size_t)((g_) * 128 + tl)) * 128 + fq * 8; \
        _Pragma("unroll") for (int ks = 0; ks < 4; ++ks) if (ks < nks) nb_fr[ks] = *(const bf16x8*)(wrow_ + ks * 32); \
        nbias = gbs[(g_) * 128 + tl]; } while (0)
    GMLP_FETCH(0);
#pragma unroll
    for (int g = 0; g < 8; ++g) {
        bf16x8 bfr[4]; u32x2 uu[4];
#pragma unroll
        for (int ks = 0; ks < 4; ++ks) bfr[ks] = nb_fr[ks];
#pragma unroll
        for (int nb = 0; nb < 4; ++nb) uu[nb] = uall[g][nb];
        const float bias = nbias;
        if (g < 7) GMLP_FETCH(g + 1);
        pg8::f32x4 c[4];
#pragma unroll
        for (int nb = 0; nb < 4; ++nb) c[nb] = (pg8::f32x4){0.f, 0.f, 0.f, 0.f};
#pragma unroll
        for (int ks = 0; ks < 4; ++ks) if (ks < nks) {
#pragma unroll
            for (int nb = 0; nb < 4; ++nb) {
                const bf16x8 afr = *(const LAS bf16x8*)(VT + (g * 64 + nb * 16 + (lane & 15)) * WROW + (((ks * 4 + fq) ^ ((nb * 2 + ((lane & 15) >> 3)) & 7)) << 4));
                c[nb] = __builtin_amdgcn_mfma_f32_16x16x32_bf16(afr, bfr[ks], c[nb], 0, 0, 0);
            }
        }
#pragma unroll
        for (int nb = 0; nb < 4; ++nb) {
            const int d0 = nb * 16 + fq * 4;
            const float v0 = bflo(uu[nb].x) * (c[nb][0] + bias), v1 = bfhi(uu[nb].x) * (c[nb][1] + bias), v2 = bflo(uu[nb].y) * (c[nb][2] + bias), v3 = bfhi(uu[nb].y) * (c[nb][3] + bias);
            ssq += (v0 * v0 + v1 * v1) + (v2 * v2 + v3 * v3);
            u32x2 o; o.x = pk2_hw(v0, v1); o.y = pk2_hw(v2, v3);
            oall[g][nb] = o;
        }
    }
#undef GMLP_FETCH
    ssq += __shfl_xor(ssq, 16); ssq += __shfl_xor(ssq, 32);
    const float rinv = __builtin_amdgcn_rsqf(ssq * (1.0f / 512.0f) + EPS);
#pragma unroll
    for (int g = 0; g < 8; ++g)
#pragma unroll
        for (int nb = 0; nb < 4; ++nb) {
            const u32x2 v = oall[g][nb]; u32x2 o; o.x = pk2_hw(bflo(v.x) * rinv, bfhi(v.x) * rinv); o.y = pk2_hw(bflo(v.y) * rinv, bfhi(v.y) * rinv);
            *(u32x2*)(mix + (size_t)(r0 + tl) * DM + 512 + g * 64 + nb * 16 + fq * 4) = o;
        }
    __syncthreads();
}

#define PHASE_PTRS() \
    unsigned char* ws = args.ws; asm volatile("" : "+s"(ws)); \
    int tidp_ = threadIdx.x; asm volatile("" : "+v"(tidp_)); \
    const int tid = tidp_, lane = tid & 63, w = __builtin_amdgcn_readfirstlane(tid >> 6), gw = bx * 8 + w, NGW = G * 8; (void)lane; (void)gw; (void)NGW; \
    const float* x = args.in[I_X]; (void)x; \
    float* b1p = (float*)(ws + WS_B1P); (void)b1p; \
    bf16* WinT = (bf16*)(ws + WS_WIN); bf16* WoT = (bf16*)(ws + WS_WO); bf16* W1T = (bf16*)(ws + WS_W1); bf16* W2T = (bf16*)(ws + WS_W2); (void)WinT; (void)WoT; (void)W1T; (void)W2T; \
    bf16* WgT = (bf16*)(ws + WS_WG); bf16* WpT = (bf16*)(ws + WS_WP); bf16* Wc1K = (bf16*)(ws + WS_WC1K); bf16* Wc1V = (bf16*)(ws + WS_WC1V); (void)WgT; (void)WpT; (void)Wc1K; (void)Wc1V; \
    float* rss1 = (float*)(ws + WS_RSS1); float* rss2 = (float*)(ws + WS_RSS2); (void)rss1; (void)rss2; \
    bf16* xb = (bf16*)(ws + WS_XB); bf16* pb = (bf16*)(ws + WS_PB); bf16* tp = (bf16*)(ws + WS_TP); bf16* h1 = (bf16*)(ws + WS_H1); (void)xb; (void)pb; (void)tp; (void)h1; \
    bf16* zq = (bf16*)(ws + WS_ZQ); bf16* zu = (bf16*)(ws + WS_ZU); bf16* zv = (bf16*)(ws + WS_ZV); bf16* mix = (bf16*)(ws + WS_MIX); (void)zq; (void)zu; (void)zv; (void)mix; \
    bf16* kvb = (bf16*)(ws + WS_KV); float* gates = (float*)(ws + WS_GATES); bf16* hdnK = (bf16*)(ws + WS_HDNK); bf16* hdnV = (bf16*)(ws + WS_HDNV); (void)kvb; (void)gates; (void)hdnK; (void)hdnV; \
    bf16* kc = (bf16*)(ws + WS_KC); bf16* vc = (bf16*)(ws + WS_VC); (void)kc; (void)vc; \
    bf16* wsb = (bf16*)(ws + WS_WSB); (void)wsb; float* hpart = (float*)(ws + WS_HDNK); (void)hpart;

__global__ void __launch_bounds__(512) fwd_megakernel(Args args) {
    extern __shared__ __attribute__((aligned(16))) unsigned char lds_raw[];
    LAS unsigned char* lds = (LAS unsigned char*)lds_raw;
    cg::grid_group grid = cg::this_grid();
    volatile LAS unsigned* MISC = (volatile LAS unsigned*)(lds + LDS_BYTES - 64);
    if (threadIdx.x < 16) MISC[threadIdx.x] = 0u;
    __syncthreads();
    if (blockIdx.x == 0) { unsigned* bw = (unsigned*)(args.ws + WS_BAR); for (int u = threadIdx.x; u < 4096; u += 512) __hip_atomic_store(bw + u, 0u, __ATOMIC_RELAXED, __HIP_MEMORY_SCOPE_AGENT); __threadfence(); }
    XcdBarrier xbar;
    const int G = gridDim.x, bx = blockIdx.x;

    #if (PHASES >> 0) & 1
    {
    PHASE_PTRS()
    if (bx < 32) {
        const int which = (bx >> 2) & 1, cgp = bx & 3, kq = bx >> 3, col = cgp * 64 + lane;
        const float* pos = args.in[which ? I_POSV : I_POSK]; const float* w1 = args.in[which ? I_CVW1 : I_CKW1]; const float* b1 = args.in[which ? I_CVB1 : I_CKB1];
        float acc8[16];
#pragma unroll
        for (int u = 0; u < 16; ++u) acc8[u] = 0.f;
        for (int k = kq * 512 + w * 64; k < kq * 512 + w * 64 + 64; k += 16) {
#pragma unroll
            for (int u = 0; u < 16; ++u) acc8[u] += pos[k + u] * w1[(size_t)(k + u) * 256 + col];
        }
        float acc = 0.f;
#pragma unroll
        for (int u = 0; u < 16; ++u) acc += acc8[u];
        LAS float* red = (LAS float*)lds;
        red[w * 64 + lane] = acc;
        __syncthreads();
        if (w == 0) { float s = kq == 0 ? b1[col] : 0.f; for (int k = 0; k < 8; ++k) s += red[k * 64 + lane]; b1p[kq * 512 + which * 256 + col] = s; }
        __syncthreads();
    }
    {
        LAS float* scr = (LAS float*)(lds + w * 16384);
        constexpr int N_IN_A = 16 * 40, N_IN_B = 16 * 32, N_IN_C = 16, N_O = 16 * 32, N_1 = 16 * 128, N_2 = 64 * 32, N_G = 16 * 32, N_P = 4 * 32, N_C = 32 * 8;
        constexpr int NITEMS = N_IN_A + N_IN_B + N_IN_C + N_O + N_1 + N_2 + N_G + N_P + 2 * N_C;
        for (int it = gw; it < NITEMS; it += NGW) {
            int r = it;
            if (r < N_IN_A) { tr_item(args.in[I_WIN], 2328, (r / 40) * 64, (r % 40) * 32, WinT, 1024, (r % 40) * 32, args.in[I_GMIX], scr, lane); continue; } r -= N_IN_A;
            if (r < N_IN_B) { tr_item(args.in[I_WIN], 2328, (r / 32) * 64, 1304 + (r % 32) * 32, WinT, 1024, 1280 + (r % 32) * 32, args.in[I_GMIX], scr, lane); continue; } r -= N_IN_B;
            if (r < N_IN_C) { tr_item(args.in[I_WIN], 2328, r * 64, 1280, WinT, 1024, 2304, args.in[I_GMIX], scr, lane); continue; } r -= N_IN_C;
            if (r < N_O) { const int k0 = (r / 32) * 64; tr_item(args.in[I_WOUT], 1024, k0, (r % 32) * 32, WoT, 1024, (r % 32) * 32, k0 < 512 ? args.in[I_OGN] : args.in[I_OGG] - 512, scr, lane); continue; } r -= N_O;
            if (r < N_1) { tr_item(args.in[I_WFF1], 4096, (r / 128) * 64, (r % 128) * 32, W1T, 1024, (r % 128) * 32, args.in[I_GFF], scr, lane); continue; } r -= N_1;
            if (r < N_2) { tr_item(args.in[I_WFF2], 1024, (r / 32) * 64, (r % 32) * 32, W2T, 4096, (r % 32) * 32, nullptr, scr, lane); continue; } r -= N_2;
            if (r < N_G) { tr_item(args.in[I_WPG], 1024, (r / 32) * 64, (r % 32) * 32, WgT, 1024, (r % 32) * 32, args.in[I_GPLE], scr, lane); continue; } r -= N_G;
            if (r < N_P) { tr_item(args.in[I_WPLE], 1024, (r / 32) * 64, (r % 32) * 32, WpT, 256, (r % 32) * 32, nullptr, scr, lane); continue; } r -= N_P;
            if (r < N_C) { tr_item(args.in[I_CKW1], 256, (r / 8) * 64, (r % 8) * 32, Wc1K, 2048, (r % 8) * 32, nullptr, scr, lane); continue; } r -= N_C;
            tr_item(args.in[I_CVW1], 256, (r / 8) * 64, (r % 8) * 32, Wc1V, 2048, (r % 8) * 32, nullptr, scr, lane);
        }
        for (int e = bx * 512 + tid; e < 8 * 128 * 128; e += G * 512) {
            const int tt = (e >> 7) & 127, sx = e & 127;
            wsb[e] = (bf16)f2bf(sx <= tt ? args.in[I_GWS][e] : 0.f);
        }
        for (int m0 = gw * 2; m0 < MROWS; m0 += NGW * 2) {
            f32x4 v[2][4]; f32x4 pv4[2]; float s[2];
#pragma unroll
            for (int r = 0; r < 2; ++r) {
                const f32x4* xr = (const f32x4*)(x + (size_t)(m0 + r) * DM) + lane;
#pragma unroll
                for (int j = 0; j < 4; ++j) v[r][j] = xr[64 * j];
                pv4[r] = *((const f32x4*)(args.in[I_P] + (size_t)(m0 + r) * DPLE) + lane);
            }
#pragma unroll
            for (int r = 0; r < 2; ++r) { s[r] = 0.f;
#pragma unroll
                for (int j = 0; j < 4; ++j) s[r] += (v[r][j][0] * v[r][j][0] + v[r][j][1] * v[r][j][1]) + (v[r][j][2] * v[r][j][2] + v[r][j][3] * v[r][j][3]); }
#pragma unroll
            for (int o = 1; o < 64; o <<= 1) { s[0] += __shfl_xor(s[0], o); s[1] += __shfl_xor(s[1], o); }
#pragma unroll
            for (int r = 0; r < 2; ++r) {
                const float rinv = __builtin_amdgcn_rsqf(s[r] * (1.0f / DM) + EPS);
                u32x2* o8 = (u32x2*)(xb + (size_t)(m0 + r) * DM) + lane;
#pragma unroll
                for (int j = 0; j < 4; ++j) { u32x2 o; o.x = pk2(v[r][j][0] * rinv, v[r][j][1] * rinv); o.y = pk2(v[r][j][2] * rinv, v[r][j][3] * rinv); o8[64 * j] = o; }
                u32x2 po; po.x = pk2(pv4[r][0], pv4[r][1]); po.y = pk2(pv4[r][2], pv4[r][3]);
                *((u32x2*)(pb + (size_t)(m0 + r) * DPLE) + lane) = po;
            }
        }
    }
        }
    grid.sync();
    xbar = xcd_barrier_post((unsigned*)(args.ws + WS_BAR), MISC + 8);

    #endif
#if (PHASES >> 1) & 1
    {
    PHASE_PTRS()
    {
        pg8::Gemm g{xb, WinT, MROWS, NINP, DM, DM, DM}; pg8::StaticOrder S; S.init(MROWS, NINP, G, bx);
        EpiRow<FIn> E{FIn{zq, kvb, zu, zv, gates}};
        pg8::gemm_phase<EpiRow<FIn>, pg8::StaticOrder, true, true>(lds, g, S, E);
    }
        }
    xcd_barrier(xbar);

    #endif
#if (PHASES >> 2) & 1
    {
    PHASE_PTRS()
    {
        const size_t nth = (size_t)G * 512, gt = (size_t)bx * 512 + tid;
        constexpr size_t NQR = 0, NKR = (size_t)MROWS * 2;
        for (size_t c = gt; c < (NQR + 2 * NKR) * 8; c += nth) {
            const size_t r = c >> 3; const int part = (int)(c & 7);
            bf16* p; const float* gn; float sc;
            if (r < NQR) { p = zq + r * 64; gn = args.in[I_QG]; sc = QSCALE; }
            else if (r < NQR + NKR) { p = kvb + 2 * KV_STRIDE + (r - NQR) * 64; gn = args.in[I_KSG]; sc = 1.f; }
            else { p = kvb + 4 * KV_STRIDE + (r - NQR - NKR) * 64; gn = args.in[I_KWG]; sc = 1.f; }
            const u32x4 v = *(const u32x4*)(p + part * 8);
            float f[8] = {bflo(v.x), bfhi(v.x), bflo(v.y), bfhi(v.y), bflo(v.z), bfhi(v.z), bflo(v.w), bfhi(v.w)};
            float s = 0.f;
#pragma unroll
            for (int e = 0; e < 8; ++e) s += f[e] * f[e];
            s += __shfl_xor(s, 1); s += __shfl_xor(s, 2); s += __shfl_xor(s, 4);
            const float rinv = __builtin_amdgcn_rsqf(s * (1.0f / 64.0f) + EPS) * sc;
#pragma unroll
            for (int e = 0; e < 8; ++e) f[e] = f[e] * rinv * gn[part * 8 + e];
            u32x4 o; o.x = pk2(f[0], f[1]); o.y = pk2(f[2], f[3]); o.z = pk2(f[4], f[5]); o.w = pk2(f[6], f[7]);
            *(u32x4*)(p + part * 8) = o;
        }
    }
    {
        const int u = bx < 128 ? bx : -1, which = (u >> 6) & 1, pm = (u >> 2) & 15, sl = u & 3;
        pg8::Gemm g{kvb + (which ? KV_STRIDE : 0) + sl * 512, (which ? Wc1V : Wc1K) + sl * 512, 4096, 256, 512, 1024, 2048}; OneUnit S{u >= 0 ? pm : -1};
        EpiRow<FPart> E{FPart{hpart + ((size_t)which * 4 + sl) * 4096 * 256}};
        pg8::gemm_phase<EpiRow<FPart>, OneUnit, true, true>(lds, g, S, E);
    }
    {
        pg8::Gemm g{pb, WpT, MROWS, DM, DPLE, DPLE, DPLE}; TpDeal S{bx, G};
        EpiRow<FPlain> E{FPlain{tp, DM}};
        pg8::gemm_phase<EpiRow<FPlain>, TpDeal, true, true>(lds, g, S, E);
    }
    {
        for (int it = bx; it < 256; it += G) gmlp_item(lds, it, zu, zv, mix, args.in[I_LNG], args.in[I_LNB], wsb, args.in[I_GBS]);
    }
        }
    xcd_barrier(xbar);

    #endif
#if (PHASES >> 3) & 1
    {
    PHASE_PTRS()
    {
    LAS float* hw = (LAS float*)(lds + w * 2048);
    for (int pr = gw; pr < 2 * 2048; pr += NGW) {
        const int p_ = __builtin_amdgcn_readfirstlane(pr), which = p_ >> 11, riA = p_ & 2047, riB = riA + 2048;
        const float* w2 = args.in[which ? I_CVW2 : I_CKW2];
        f32x4 hb = *(const f32x4*)(b1p + which * 256 + lane * 4);
#pragma unroll
        for (int kq = 1; kq < 4; ++kq) hb += *(const f32x4*)(b1p + kq * 512 + which * 256 + lane * 4);
        const float* hpA = hpart + ((size_t)which * 4 * 4096 + riA) * 256 + lane * 4;
        const float* hpB = hpart + ((size_t)which * 4 * 4096 + riB) * 256 + lane * 4;
        f32x4 hA = hb, hB = hb;
#pragma unroll
        for (int sl = 0; sl < 4; ++sl) { hA += *(const f32x4*)(hpA + (size_t)sl * 4096 * 256); hB += *(const f32x4*)(hpB + (size_t)sl * 4096 * 256); }
#pragma unroll
        for (int e = 0; e < 4; ++e) { hA[e] = gelu_tanh(hA[e]); hB[e] = gelu_tanh(hB[e]); }
        *(LAS f32x4*)(hw + lane * 4) = hA; *(LAS f32x4*)(hw + 256 + lane * 4) = hB;
        const float bias2 = args.in[which ? I_CVB2 : I_CKB2][lane];
        float accA = bias2, accB = bias2;
#pragma unroll 8
        for (int k2 = 0; k2 < 256; k2 += 4) { const f32x4 ha = *(const LAS f32x4*)(hw + k2), hc = *(const LAS f32x4*)(hw + 256 + k2);
            const float w0 = w2[k2 * 64 + lane], w1 = w2[(k2 + 1) * 64 + lane], w2v = w2[(k2 + 2) * 64 + lane], w3 = w2[(k2 + 3) * 64 + lane];
            accA += ha[0] * w0 + ha[1] * w1 + ha[2] * w2v + ha[3] * w3; accB += hc[0] * w0 + hc[1] * w1 + hc[2] * w2v + hc[3] * w3; }
#pragma unroll
        for (int hh2 = 0; hh2 < 2; ++hh2) {
            const int ri = hh2 ? riB : riA; float acc = hh2 ? accB : accA;
            bf16* op = which ? vc + (size_t)(ri >> 8) * 16384 + (size_t)((ri & 255) >> 6) * 4096 + (size_t)lane * 64 + (ri & 63) : kc + (size_t)ri * 64 + lane;
            if ((ri & 255) == 255) { *op = 0; continue; }
            if (!which) { const float ssum = wave_sum(acc * acc); acc *= __builtin_amdgcn_rsqf(ssum * (1.0f / 64.0f) + EPS) * args.in[I_KCG][lane]; }
            *op = (bf16)f2bf(acc);
        }
    }
    }
        }
    xcd_barrier(xbar);

    #endif
#if (PHASES >> 4) & 1
    {
    PHASE_PTRS()
    for (int pi = bx; pi < 256; pi += G) {
        const int b = pi >> 5, qa = pi & 31;
#pragma nounroll
        for (int hh = 0; hh < 2; ++hh) att::attn_item(lds, b, hh ? qa : 63 - qa, args.in[I_QG], zq, kvb, kc, vc, gates, mix);
    }
        }
    xcd_barrier(xbar);

    #endif
#if (PHASES >> 5) & 1
    {
    PHASE_PTRS()
    {
        pg8::Gemm g{mix, WoT, MROWS, DM, DM, DM, DM}; pg8::StaticOrder S; S.init(MROWS, DM, G, bx);
        EpiRowP<FResA> E{FResA{x, xb, rss1}};
        pg8::gemm_phase<EpiRowP<FResA>, pg8::StaticOrder, true, true>(lds, g, S, E);
    }
        }
    xcd_barrier(xbar);
    #endif
#if (PHASES >> 6) & 1
    {
    PHASE_PTRS()
    {
        pg8::Gemm g{xb, W1T, MROWS, FF, DM, DM, DM}; pg8::StaticOrder S; S.init(MROWS, FF, G, bx);
        EpiRowP<FFF1> E{FFF1{h1, rss1}};
        pg8::gemm_phase<EpiRowP<FFF1>, pg8::StaticOrder, true, true>(lds, g, S, E);
    }
        }
    xcd_barrier(xbar);
    #endif
#if (PHASES >> 7) & 1
    {
    PHASE_PTRS()
    {
        pg8::Gemm g{h1, W2T, MROWS, DM, FF, FF, FF}; pg8::StaticOrder S; S.init(MROWS, DM, G, bx);
        EpiRowP<FResB> E{FResB{args.out, xb, rss2}};
        pg8::gemm_phase<EpiRowP<FResB>, pg8::StaticOrder, true, true>(lds, g, S, E);
    }
        }
    xcd_barrier(xbar);
    #endif
#if (PHASES >> 8) & 1
    {
    PHASE_PTRS()
    {
        pg8::Gemm g{xb, WgT, MROWS, DM, DM, DM, DM}; pg8::StaticOrder S; S.init(MROWS, DM, G, bx);
        EpiRow<FGate> E{FGate{args.out, tp, rss2}};
        pg8::gemm_phase<EpiRow<FGate>, pg8::StaticOrder, true, true>(lds, g, S, E);
    }
    }
    #endif
}

extern "C" void kernel_launch(void* const* d_in, const int* in_sizes, int n_in, void* d_out, int out_size, void* d_ws, size_t ws_size, hipStream_t stream) {
    static int grid = 0;
    if (!grid) {
        int dev = 0, cus = 0, per_cu = 0;
        hipGetDevice(&dev);
        hipDeviceGetAttribute(&cus, hipDeviceAttributeMultiprocessorCount, dev);
        hipFuncSetAttribute((const void*)fwd_megakernel, hipFuncAttributeMaxDynamicSharedMemorySize, LDS_BYTES);
        hipOccupancyMaxActiveBlocksPerMultiprocessor(&per_cu, (const void*)fwd_megakernel, 512, LDS_BYTES);
        if (per_cu < 1) per_cu = 1;
        grid = cus * per_cu;
        if (n_in != 31 || ws_size < WS_BIG + 256 * MiB) fprintf(stderr, "kernel_launch: unexpected n_in %d / ws %zu\n", n_in, ws_size);
    }
    Args a{};
    for (int i = 0; i < 31; ++i) a.in[i] = (const float*)d_in[i];
    a.out = (float*)d_out; a.ws = (unsigned char*)d_ws;
    void* args[] = {&a};
    hipError_t e = hipLaunchCooperativeKernel((void*)fwd_megakernel, dim3(grid), dim3(512), args, LDS_BYTES, stream);
    if (e != hipSuccess) fprintf(stderr, "cooperative launch failed: %s (grid %d)\n", hipGetErrorString(e), grid);
}
```
